# Optimizing an MI355X kernel written in HIP

```python
import math
import jax, jax.numpy as jnp
from jax import lax
import numpy as np

D_MODEL = 2048
BATCH = 2
SEQ = 8192
DEPTH = 4

N_MIXERS = 3
N_LAYERS_A = (DEPTH + 2) // 3
N_LAYERS_B = (DEPTH + 1) // 3
N_LAYERS_C = DEPTH // 3
RMS_EPS = 1e-6

ATTN_HEAD_DIM = 64
ATTN_HEADS = D_MODEL // ATTN_HEAD_DIM
ATTN_KV_HEADS = ATTN_HEADS // 8
ATTN_GROUP = ATTN_HEADS // ATTN_KV_HEADS
WINDOW = 128
ATTN_BLOCK = 128
N_HALO = WINDOW // ATTN_BLOCK
ATTN_KEYS = (2 * N_HALO + 1) * ATTN_BLOCK

SSM_GROUP_CH = 16
SSM_GROUPS = D_MODEL // SSM_GROUP_CH
SSM_STATE = 64
SSM_DIRS = 2
DT_MIN = 1e-3
DT_MAX = 1e-1

MLA_HEADS = 16
MLA_Q_LORA = 512
MLA_KV_LORA = 512
MLA_NOPE = 128
MLA_ROPE = 64
MLA_V = 128
MLA_BLOCK = 128
ROPE_THETA = 10000.0

D_FF = 5632
CONV_WIDTH = 3

kernel_name = "hybrid_swa_s5_mla_convffn_encoder"


def _rmsnorm(x, g):
    xf = x.astype(jnp.float32)
    y = xf * lax.rsqrt(jnp.mean(xf * xf, axis=-1, keepdims=True) + RMS_EPS)
    return (y * g.astype(jnp.float32)).astype(x.dtype)


def _alibi_slopes(n_heads):
    return (2.0 ** (-8.0 * np.arange(1, n_heads + 1) / n_heads)).astype(np.float32)


def _windowed_gqa_alibi_sink(h, w_qkv, w_o, sink):
    B, S, _ = h.shape
    nb = S // ATTN_BLOCK
    H, KV, G, dh = ATTN_HEADS, ATTN_KV_HEADS, ATTN_GROUP, ATTN_HEAD_DIM
    qkv = h @ w_qkv
    q, k, v = jnp.split(qkv, [H * dh, (H + KV) * dh], axis=-1)
    q = q.reshape(B, nb, ATTN_BLOCK, KV, G, dh)
    pad = N_HALO * ATTN_BLOCK
    padw = ((0, 0), (pad, pad), (0, 0), (0, 0))
    kp = jnp.pad(k.reshape(B, S, KV, dh), padw).reshape(B, nb + 2 * N_HALO, ATTN_BLOCK, KV, dh)
    vp = jnp.pad(v.reshape(B, S, KV, dh), padw).reshape(B, nb + 2 * N_HALO, ATTN_BLOCK, KV, dh)
    kb = jnp.concatenate([kp[:, o:o + nb] for o in range(2 * N_HALO + 1)], axis=2)
    vb = jnp.concatenate([vp[:, o:o + nb] for o in range(2 * N_HALO + 1)], axis=2)
    s = jnp.einsum('bnqkgd,bnskd->bnkgqs', q, kb,
                   preferred_element_type=jnp.float32) * (dh ** -0.5)
    rel = jnp.arange(ATTN_KEYS)[None, :] - pad - jnp.arange(ATTN_BLOCK)[:, None]
    key_idx = jnp.arange(nb)[:, None] * ATTN_BLOCK - pad + jnp.arange(ATTN_KEYS)[None, :]
    valid = (jnp.abs(rel) <= WINDOW)[None] & ((key_idx >= 0) & (key_idx < S))[:, None, :]
    slopes = jnp.asarray(_alibi_slopes(H)).reshape(KV, G)
    bias = -slopes[:, :, None, None] * jnp.abs(rel).astype(jnp.float32)
    s = jnp.where(valid[None, :, None, None], s + bias, -jnp.inf)
    sink_l = sink.astype(jnp.float32).reshape(KV, G)[:, :, None, None]
    m = jnp.maximum(s.max(axis=-1, keepdims=True), sink_l)
    p = jnp.exp(s - m)
    p = p / (p.sum(axis=-1, keepdims=True) + jnp.exp(sink_l - m))
    o = jnp.einsum('bnkgqs,bnskd->bnqkgd', p.astype(vb.dtype), vb)
    return o.reshape(B, S, H * dh) @ w_o


def _complex_recurrence_combine(e1, e2):
    a1r, a1i, b1r, b1i = e1
    a2r, a2i, b2r, b2i = e2
    return (a2r * a1r - a2i * a1i,
            a2r * a1i + a2i * a1r,
            a2r * b1r - a2i * b1i + b2r,
            a2r * b1i + a2i * b1r + b2i)


def _s5_direction(ug, a_re, a_im, log_step, b_re, b_im, c_re, c_im, reverse):
    S = ug.shape[1]
    a_re = a_re.astype(jnp.float32)
    a_im = a_im.astype(jnp.float32)
    step = jnp.exp(log_step.astype(jnp.float32))[:, None]
    mag = jnp.exp(step * a_re)
    lb_re = mag * jnp.cos(step * a_im)
    lb_im = mag * jnp.sin(step * a_im)
    n_re, n_im = lb_re - 1.0, lb_im
    den = a_re * a_re + a_im * a_im
    coef_re = (n_re * a_re + n_im * a_im) / den
    coef_im = (n_im * a_re - n_re * a_im) / den
    b_re = b_re.astype(jnp.float32)
    b_im = b_im.astype(jnp.float32)
    bb_re = coef_re[..., None] * b_re - coef_im[..., None] * b_im
    bb_im = coef_re[..., None] * b_im + coef_im[..., None] * b_re
    bu_re = jnp.einsum('bsgc,gnc->bsgn', ug, bb_re)
    bu_im = jnp.einsum('bsgc,gnc->bsgn', ug, bb_im)
    lam_re = jnp.broadcast_to(lb_re, (1, S) + lb_re.shape)
    lam_im = jnp.broadcast_to(lb_im, (1, S) + lb_im.shape)
    _, _, x_re, x_im = lax.associative_scan(
        _complex_recurrence_combine, (lam_re, lam_im, bu_re, bu_im), reverse=reverse, axis=1)
    return (jnp.einsum('bsgn,gcn->bsgc', x_re, c_re.astype(jnp.float32))
            - jnp.einsum('bsgn,gcn->bsgc', x_im, c_im.astype(jnp.float32)))


def _s5_bidirectional_glu(h, a_re, a_im, log_step, b_re, b_im, c_re, c_im, d_skip, w_glu, b_glu):
    B, S, D = h.shape
    u = h.astype(jnp.float32)
    ug = u.reshape(B, S, SSM_GROUPS, SSM_GROUP_CH)
    y = d_skip.astype(jnp.float32) * u
    for dirn in range(SSM_DIRS):
        y = y + _s5_direction(ug, a_re[dirn], a_im[dirn], log_step[dirn], b_re[dirn], b_im[dirn],
                              c_re[dirn], c_im[dirn], reverse=(dirn == 1)).reshape(B, S, D)
    z = jax.nn.gelu(y)
    out = z * jax.nn.sigmoid(z @ w_glu.astype(jnp.float32) + b_glu.astype(jnp.float32))
    return out.astype(h.dtype)


def _rope(x, cos, sin):
    half = x.shape[-1] // 2
    x1, x2 = x[..., :half], x[..., half:]
    return jnp.concatenate([x1 * cos - x2 * sin, x2 * cos + x1 * sin], axis=-1).astype(x.dtype)


def _mla(h, w_dqkv, q_norm, kv_norm, w_uq, w_ukv, w_o):
    B, S, _ = h.shape
    H = MLA_HEADS
    nb = S // MLA_BLOCK
    d = h @ w_dqkv
    c_q, c_kv, k_rope = jnp.split(d, [MLA_Q_LORA, MLA_Q_LORA + MLA_KV_LORA], axis=-1)
    c_q = _rmsnorm(c_q, q_norm)
    c_kv = _rmsnorm(c_kv, kv_norm)
    q = (c_q @ w_uq).reshape(B, S, H, MLA_NOPE + MLA_ROPE)
    q_nope, q_rope = jnp.split(q, [MLA_NOPE], axis=-1)
    kv = (c_kv @ w_ukv).reshape(B, S, H, MLA_NOPE + MLA_V)
    k_nope, v = jnp.split(kv, [MLA_NOPE], axis=-1)
    half = MLA_ROPE // 2
    pos = jnp.arange(S, dtype=jnp.float32)
    inv = ROPE_THETA ** (-jnp.arange(half, dtype=jnp.float32) / half)
    ang = pos[:, None] * inv[None, :]
    cos, sin = jnp.cos(ang), jnp.sin(ang)
    q_rope = _rope(q_rope, cos[:, None, :], sin[:, None, :])
    k_rope = _rope(k_rope, cos, sin)
    scale = (MLA_NOPE + MLA_ROPE) ** -0.5

    def q_block(args):
        qn, qr = args
        s = (jnp.einsum('bqhd,bshd->bhqs', qn, k_nope, preferred_element_type=jnp.float32)
             + jnp.einsum('bqhd,bsd->bhqs', qr, k_rope, preferred_element_type=jnp.float32)) * scale
        p = jax.nn.softmax(s, axis=-1)
        return jnp.einsum('bhqs,bshd->bqhd', p.astype(v.dtype), v)

    qn_b = q_nope.reshape(B, nb, MLA_BLOCK, H, MLA_NOPE).swapaxes(0, 1)
    qr_b = q_rope.reshape(B, nb, MLA_BLOCK, H, MLA_ROPE).swapaxes(0, 1)
    o = lax.map(q_block, (qn_b, qr_b))
    o = o.swapaxes(0, 1).reshape(B, S, H * MLA_V)
    return o @ w_o


def _conv_ffn(h, w_up, conv_w, conv_b, w_down):
    S = h.shape[1]
    u = h @ w_up
    r = CONV_WIDTH // 2
    up = jnp.pad(u, ((0, 0), (r, r), (0, 0)))
    c = conv_b + sum(conv_w[t] * up[:, t:t + S] for t in range(CONV_WIDTH))
    gate, val = jnp.split(c, 2, axis=-1)
    return (jax.nn.silu(gate) * val) @ w_down


def setup_inputs(seed: int = 0) -> dict:
    key = jax.random.key(seed)
    ks = iter(jax.random.split(key, 32))
    f32 = jnp.float32

    def nrm(shape, scale):
        return jax.random.normal(next(ks), shape, f32) * scale

    D = D_MODEL
    attn_qkv_w = (ATTN_HEADS + 2 * ATTN_KV_HEADS) * ATTN_HEAD_DIM
    ssm_shape = (N_LAYERS_B, SSM_DIRS, SSM_GROUPS, SSM_STATE)
    n_idx = jnp.arange(SSM_STATE, dtype=f32)
    return {
        "x": nrm((BATCH, SEQ, D), 1.0),
        "mix_norm": 1.0 + nrm((DEPTH, D), 0.02),
        "ffn_norm": 1.0 + nrm((DEPTH, D), 0.02),
        "final_norm": 1.0 + nrm((D,), 0.02),
        "attn_w_qkv": nrm((N_LAYERS_A, D, attn_qkv_w), D ** -0.5),
        "attn_w_o": nrm((N_LAYERS_A, ATTN_HEADS * ATTN_HEAD_DIM, D), (ATTN_HEADS * ATTN_HEAD_DIM) ** -0.5),
        "attn_sink": nrm((N_LAYERS_A, ATTN_HEADS), 0.5),
        "ssm_a_re": -0.5 + nrm(ssm_shape, 0.01),
        "ssm_a_im": jnp.pi * n_idx + nrm(ssm_shape, 0.01),
        "ssm_log_step": jax.random.uniform(next(ks), (N_LAYERS_B, SSM_DIRS, SSM_GROUPS), f32,
                                           math.log(DT_MIN), math.log(DT_MAX)),
        "ssm_b_re": nrm(ssm_shape + (SSM_GROUP_CH,), (2 * SSM_GROUP_CH) ** -0.5),
        "ssm_b_im": nrm(ssm_shape + (SSM_GROUP_CH,), (2 * SSM_GROUP_CH) ** -0.5),
        "ssm_c_re": nrm((N_LAYERS_B, SSM_DIRS, SSM_GROUPS, SSM_GROUP_CH, SSM_STATE), SSM_STATE ** -0.5),
        "ssm_c_im": nrm((N_LAYERS_B, SSM_DIRS, SSM_GROUPS, SSM_GROUP_CH, SSM_STATE), SSM_STATE ** -0.5),
        "ssm_d": nrm((N_LAYERS_B, D), 1.0),
        "ssm_w_glu": nrm((N_LAYERS_B, D, D), D ** -0.5),
        "ssm_b_glu": nrm((N_LAYERS_B, D), 0.01),
        "mla_w_dqkv": nrm((N_LAYERS_C, D, MLA_Q_LORA + MLA_KV_LORA + MLA_ROPE), D ** -0.5),
        "mla_q_norm": 1.0 + nrm((N_LAYERS_C, MLA_Q_LORA), 0.02),
        "mla_kv_norm": 1.0 + nrm((N_LAYERS_C, MLA_KV_LORA), 0.02),
        "mla_w_uq": nrm((N_LAYERS_C, MLA_Q_LORA, MLA_HEADS * (MLA_NOPE + MLA_ROPE)), MLA_Q_LORA ** -0.5),
        "mla_w_ukv": nrm((N_LAYERS_C, MLA_KV_LORA, MLA_HEADS * (MLA_NOPE + MLA_V)), MLA_KV_LORA ** -0.5),
        "mla_w_o": nrm((N_LAYERS_C, MLA_HEADS * MLA_V, D), (MLA_HEADS * MLA_V) ** -0.5),
        "ffn_w_up": nrm((DEPTH, D, 2 * D_FF), D ** -0.5),
        "ffn_conv_w": nrm((DEPTH, CONV_WIDTH, 2 * D_FF), CONV_WIDTH ** -0.5),
        "ffn_conv_b": nrm((DEPTH, 2 * D_FF), 0.01),
        "ffn_w_down": nrm((DEPTH, D_FF, D), D_FF ** -0.5),
    }


def reference(x, mix_norm, ffn_norm, final_norm, attn_w_qkv, attn_w_o, attn_sink,
              ssm_a_re, ssm_a_im, ssm_log_step, ssm_b_re, ssm_b_im, ssm_c_re, ssm_c_im,
              ssm_d, ssm_w_glu, ssm_b_glu, mla_w_dqkv, mla_q_norm, mla_kv_norm, mla_w_uq,
              mla_w_ukv, mla_w_o, ffn_w_up, ffn_conv_w, ffn_conv_b, ffn_w_down):
    for i in range(DEPTH):
        kind = i % N_MIXERS
        j = i // N_MIXERS
        h = _rmsnorm(x, mix_norm[i])
        if kind == 0:
            h = _windowed_gqa_alibi_sink(h, attn_w_qkv[j], attn_w_o[j], attn_sink[j])
        elif kind == 1:
            h = _s5_bidirectional_glu(h, ssm_a_re[j], ssm_a_im[j], ssm_log_step[j], ssm_b_re[j],
                                      ssm_b_im[j], ssm_c_re[j], ssm_c_im[j], ssm_d[j],
                                      ssm_w_glu[j], ssm_b_glu[j])
        else:
            h = _mla(h, mla_w_dqkv[j], mla_q_norm[j], mla_kv_norm[j], mla_w_uq[j],
                     mla_w_ukv[j], mla_w_o[j])
        x = x + h
        x = x + _conv_ffn(_rmsnorm(x, ffn_norm[i]), ffn_w_up[i], ffn_conv_w[i],
                          ffn_conv_b[i], ffn_w_down[i])
    return _rmsnorm(x, final_norm)
```

```cpp
#include <hip/hip_runtime.h>
#include <hip/hip_cooperative_groups.h>
#include <cstdio>
#include <cstdint>
namespace cg = cooperative_groups;

#define LAS __attribute__((address_space(3)))
typedef unsigned short bf16_t;
typedef short bf16x8 __attribute__((ext_vector_type(8)));
typedef short v4i16_t __attribute__((ext_vector_type(4)));
typedef float f32x4 __attribute__((ext_vector_type(4)));
typedef float f32x16 __attribute__((ext_vector_type(16)));
typedef unsigned u32x4 __attribute__((ext_vector_type(4)));
typedef unsigned u32x2 __attribute__((ext_vector_type(2)));

constexpr int SEQ = 8192, BATCH = 2, T = BATCH * SEQ, D = 2048, DFF = 5632, NUP = 2 * DFF;
constexpr int NQKV = 2560, NDQ = 1280  , NUQ = 3072, NUKV = 4096;
constexpr float EPS = 1e-6f;
constexpr float LOG2E = 1.4426950408889634f;

constexpr size_t MiB = 1u << 20;
constexpr size_t WS_BAR = 0;
constexpr size_t WS_ROPE = 1 * MiB;
constexpr size_t WS_KR = 3 * MiB;
constexpr size_t WS_W = 8 * MiB;
constexpr size_t W_QKV0 = WS_W, W_QKV1 = W_QKV0 + 10 * MiB, W_WO0 = W_QKV1 + 10 * MiB, W_WO1 = W_WO0 + 8 * MiB, W_GLU = W_WO1 + 8 * MiB;
constexpr size_t W_DQ = W_GLU + 8 * MiB, W_UQ = W_DQ + 5 * MiB, W_UKV = W_UQ + 3 * MiB, W_MWO = W_UKV + 4 * MiB;
constexpr size_t W_UP = W_MWO + 8 * MiB;
constexpr size_t W_DOWN = W_UP + 176 * MiB;
constexpr size_t WS_XB = W_DOWN + 88 * MiB;
constexpr size_t WS_OB = WS_XB + 64 * MiB;
constexpr size_t WS_QKV = WS_OB + 64 * MiB;
constexpr size_t WS_CQ = WS_QKV, WS_CKV = WS_CQ + 16 * MiB, WS_Q = WS_CKV + 16 * MiB + 16 * MiB, WS_KV = WS_Q + 96 * MiB;
constexpr size_t WS_U = WS_KV + 128 * MiB;
constexpr size_t WS_YF = WS_U, WS_YR = WS_U + 128 * MiB;
constexpr size_t WS_ACT = WS_U + 352 * MiB;
constexpr size_t WS_SSQP = WS_ACT + 176 * MiB;
constexpr size_t WS_S5P = WS_SSQP + 24 * MiB;
constexpr size_t WS_END = WS_S5P + 4 * MiB;

constexpr int LDS_BYTES = 147456;

__device__ __forceinline__ unsigned cvt_pk_bf16(float lo, float hi) { unsigned r; asm volatile("v_cvt_pk_bf16_f32 %0, %1, %2" : "=v"(r) : "v"(lo), "v"(hi)); return r; }
__device__ __forceinline__ float bf2f(unsigned short u) { return __uint_as_float((unsigned)u << 16); }
__device__ __forceinline__ float bflo(unsigned w) { return __uint_as_float(w << 16); }
__device__ __forceinline__ float bfhi(unsigned w) { return __uint_as_float(w & 0xffff0000u); }
__device__ __forceinline__ float wave_sum(float v) {
#pragma unroll
    for (int o = 1; o < 64; o <<= 1) v += __shfl_xor(v, o);
    return v;
}
__device__ __forceinline__ void split_bf16x8(const f32x4 a, const f32x4 b, bf16x8& hi, bf16x8& lo) {
    u32x4 h, l;
    h.x = cvt_pk_bf16(a[0], a[1]); h.y = cvt_pk_bf16(a[2], a[3]); h.z = cvt_pk_bf16(b[0], b[1]); h.w = cvt_pk_bf16(b[2], b[3]);
    l.x = cvt_pk_bf16(a[0] - bflo(h.x), a[1] - bfhi(h.x)); l.y = cvt_pk_bf16(a[2] - bflo(h.y), a[3] - bfhi(h.y));
    l.z = cvt_pk_bf16(b[0] - bflo(h.z), b[1] - bfhi(h.z)); l.w = cvt_pk_bf16(b[2] - bflo(h.w), b[3] - bfhi(h.w));
    hi = __builtin_bit_cast(bf16x8, h); lo = __builtin_bit_cast(bf16x8, l);
}
__device__ __forceinline__ size_t ssq_at(int row, int pn) { return ((size_t)((row >> 8) * 8 + pn) * 256 + (row & 255)) * 4; }
template <int NP> __device__ __forceinline__ float row_rs(const float* ssqp, int row, int fq, float inv_dim) {
    float s;
    if constexpr (NP == 32) { const f32x4 a = *(const f32x4*)(ssqp + ssq_at(row, 2 * fq)), b = *(const f32x4*)(ssqp + ssq_at(row, 2 * fq + 1)); s = ((a[0] + a[1]) + (a[2] + a[3])) + ((b[0] + b[1]) + (b[2] + b[3])); }
    else { const f32x4 a = *(const f32x4*)(ssqp + ssq_at(row, fq & 1)); s = (fq < 2) ? ((a[0] + a[1]) + (a[2] + a[3])) : 0.f; }
    s += __shfl_xor(s, 16); s += __shfl_xor(s, 32);
    return __builtin_amdgcn_rsqf(s * inv_dim + EPS);
}
__device__ __forceinline__ void sincos_d(double x, double& s, double& c) {
    const double kd = rint(x * 0.63661977236758134308);
    double r = fma(-kd, 1.57079632679489655800e+00, x); r = fma(-kd, 6.12323399573676603587e-17, r);
    const int k = (int)kd; const double r2 = r * r;
    const double sp = r * (1.0 + r2 * (-1.0 / 6.0 + r2 * (1.0 / 120.0 + r2 * (-1.0 / 5040.0 + r2 * (1.0 / 362880.0 + r2 * (-1.0 / 39916800.0 + r2 * (1.0 / 6227020800.0 + r2 * (-1.0 / 1307674368000.0))))))));
    const double cp = 1.0 + r2 * (-0.5 + r2 * (1.0 / 24.0 + r2 * (-1.0 / 720.0 + r2 * (1.0 / 40320.0 + r2 * (-1.0 / 3628800.0 + r2 * (1.0 / 479001600.0 + r2 * (-1.0 / 87178291200.0 + r2 * (1.0 / 20922789888000.0))))))));
    const int q = k & 3;
    s = (q == 0) ? sp : (q == 1) ? cp : (q == 2) ? -sp : -cp;
    c = (q == 0) ? cp : (q == 1) ? -sp : (q == 2) ? -cp : sp;
}
__device__ __forceinline__ double exp_d(double x) {
    const double kd = rint(x * 1.44269504088896338700);
    double r = fma(-kd, 6.93147180369123816490e-01, x); r = fma(-kd, 1.90821492927058770002e-10, r);
    double p = 1.0 / 6227020800.0;
    p = p * r + 1.0 / 479001600.0; p = p * r + 1.0 / 39916800.0; p = p * r + 1.0 / 3628800.0; p = p * r + 1.0 / 362880.0; p = p * r + 1.0 / 40320.0;
    p = p * r + 1.0 / 5040.0; p = p * r + 1.0 / 720.0; p = p * r + 1.0 / 120.0; p = p * r + 1.0 / 24.0; p = p * r + 1.0 / 6.0; p = p * r + 0.5; p = p * r + 1.0; p = p * r + 1.0;
    const long long bits = ((long long)((int)kd + 1023)) << 52;
    return p * __longlong_as_double(bits);
}

namespace pg8 {
constexpr int BM = 256, BK = 64, HALF = 128, HTB = HALF * BK * 2, STAGE_BYTES = 8 * HTB, NXCD = 8, WGM = 8;
__host__ __device__ __forceinline__ int lds_byte(int r, int c) { const int st = (r >> 4) * 2 + (c >> 5), rr = r & 15, cc = c & 31, ob = rr * 64 + cc * 2; return st * 1024 + (ob ^ (((ob >> 9) & 1) << 5)); }
__host__ __device__ __forceinline__ void stage_rc(int b, int& R, int& C) { const int st = b / 1024, sb = b % 1024, swz = sb ^ (((sb >> 9) & 1) << 5); R = (st >> 1) * 16 + swz / 64; C = (st & 1) * 32 + (swz % 64) / 2; }
__host__ __device__ __forceinline__ int perm32(int rho) { const int n = rho >> 4, i = rho & 15; return 8 * (i >> 2) + 4 * n + (i & 3); }
struct Unit { int pm, pn; };
struct Gemm { const bf16_t* A; const bf16_t* Bt; int M, N, K, lda, ldb; };
struct StaticOrder {
    int nM, nN, nwg, G, c;
    __device__ void init(int M, int N, int G_, int c_) { nM = M / BM; nN = N / BM; nwg = nM * nN; G = G_; c = c_; }
    __device__ bool next(int i, Unit& u) const {
        const long L = (long)i * G + c; if (L >= nwg) return false;
        int wgid = (int)L; { const int q = nwg / NXCD, r = nwg % NXCD, xcd = wgid % NXCD, off = wgid / NXCD; wgid = (xcd < r ? xcd * (q + 1) : r * (q + 1) + (xcd - r) * q) + off; }
        const int nig = WGM * nN, gid = wgid / nig, fm = gid * WGM, gsz = (nM - fm) < WGM ? (nM - fm) : WGM;
        u.pm = fm + ((wgid % nig) % gsz); u.pn = (wgid % nig) / gsz; return true;
    }
};

struct EpiScaleBf16 {
    static constexpr bool PERM = true;
    bf16_t* O; int ldc; const float* ssq; float inv_dim; bool np8;
    __device__ __forceinline__ void operator()(const f32x4 (&acc)[2][2][4][2], const Unit& u, int wr, int wc, int fr, int fq) const {
        const int row0 = u.pm * BM + wr * 64 + fr, col0 = u.pn * BM + wc * 32 + 8 * fq;
#pragma unroll
        for (int ai = 0; ai < 2; ++ai)
#pragma unroll
            for (int m = 0; m < 4; ++m) {
                const int row = row0 + ai * HALF + m * 16;
                const float rs = np8 ? row_rs<8>(ssq, row, fq, inv_dim) : row_rs<32>(ssq, row, fq, inv_dim);
                bf16_t* rowp = O + (size_t)row * ldc + col0;
#pragma unroll
                for (int bj = 0; bj < 2; ++bj) {
                    const f32x4 v0 = acc[ai][bj][m][0] * rs, v1 = acc[ai][bj][m][1] * rs;
                    u32x4 w; w.x = cvt_pk_bf16(v0[0], v0[1]); w.y = cvt_pk_bf16(v0[2], v0[3]); w.z = cvt_pk_bf16(v1[0], v1[1]); w.w = cvt_pk_bf16(v1[2], v1[3]);
                    *(u32x4*)(rowp + bj * HALF) = w;
                }
            }
    }
};
struct EpiResidual {
    static constexpr bool PERM = false;
    const float* Xin; float* Xout; bf16_t* XB; float* ssq_out; const bf16_t* Z; const float* bias;
    __device__ __forceinline__ void operator()(const f32x4 (&acc)[2][2][4][2], const Unit& u, int wr, int wc, int fr, int fq) const {
        const int row0 = u.pm * BM + wr * 64 + fr, col0 = u.pn * BM + wc * 32 + 4 * fq;
#pragma unroll
        for (int ai = 0; ai < 2; ++ai)
#pragma unroll
            for (int m = 0; m < 4; ++m) {
                const int row = row0 + ai * HALF + m * 16; const size_t off = (size_t)row * D + col0; float ss = 0.f;
#pragma unroll
                for (int bj = 0; bj < 2; ++bj)
#pragma unroll
                    for (int n = 0; n < 2; ++n) {
                        const size_t o = off + bj * HALF + n * 16; f32x4 a = acc[ai][bj][m][n];
                        if (Z) {
                            const u32x2 zz = *(const u32x2*)(Z + o); const f32x4 bv = *(const f32x4*)(bias + col0 + bj * HALF + n * 16);
                            const float z0 = bflo(zz.x), z1 = bfhi(zz.x), z2 = bflo(zz.y), z3 = bfhi(zz.y);
                            a[0] = z0 * __builtin_amdgcn_rcpf(1.f + __expf(-(a[0] + bv[0]))); a[1] = z1 * __builtin_amdgcn_rcpf(1.f + __expf(-(a[1] + bv[1])));
                            a[2] = z2 * __builtin_amdgcn_rcpf(1.f + __expf(-(a[2] + bv[2]))); a[3] = z3 * __builtin_amdgcn_rcpf(1.f + __expf(-(a[3] + bv[3])));
                        }
                        f32x4 x = *(const f32x4*)(Xin + o); x = x + a;
                        *(f32x4*)(Xout + o) = x;
                        u32x2 w; w.x = cvt_pk_bf16(x[0], x[1]); w.y = cvt_pk_bf16(x[2], x[3]); *(u32x2*)(XB + o) = w;
                        ss += (x[0] * x[0] + x[1] * x[1]) + (x[2] * x[2] + x[3] * x[3]);
                    }
                ss += __shfl_xor(ss, 16); ss += __shfl_xor(ss, 32);
                if (fq == 0) ssq_out[ssq_at(row, u.pn) + wc] = ss;
                asm volatile("" ::: "memory");
            }
    }
};
struct EpiDqkv {
    static constexpr bool PERM = false;
    bf16_t* CQ; bf16_t* CKV; bf16_t* KR; const float* ssq_in; float* ssq_q; float* ssq_kv; const float* cosT; const float* sinT;
    __device__ __forceinline__ void operator()(const f32x4 (&acc)[2][2][4][2], const Unit& u, int wr, int wc, int fr, int fq) const {
        const int row0 = u.pm * BM + wr * 64 + fr, lcol0 = wc * 32 + 4 * fq;
#pragma unroll
        for (int ai = 0; ai < 2; ++ai)
#pragma unroll
            for (int m = 0; m < 4; ++m) {
                const int row = row0 + ai * HALF + m * 16;
                const float rs = row_rs<32>(ssq_in, row, fq, 1.f / D);
                if (u.pn < 4) {
                    bf16_t* dst = (u.pn < 2 ? CQ : CKV) + (size_t)row * 512 + (u.pn & 1) * 256 + lcol0; float ss = 0.f;
#pragma unroll
                    for (int bj = 0; bj < 2; ++bj)
#pragma unroll
                        for (int n = 0; n < 2; ++n) {
                            const f32x4 v = acc[ai][bj][m][n] * rs;
                            u32x2 w; w.x = cvt_pk_bf16(v[0], v[1]); w.y = cvt_pk_bf16(v[2], v[3]); *(u32x2*)(dst + bj * HALF + n * 16) = w;
                            ss += (v[0] * v[0] + v[1] * v[1]) + (v[2] * v[2] + v[3] * v[3]);
                        }
                    ss += __shfl_xor(ss, 16); ss += __shfl_xor(ss, 32);
                    if (fq == 0) (u.pn < 2 ? ssq_q : ssq_kv)[ssq_at(row, u.pn & 1) + wc] = ss;
                } else if (wc < 2) {
                    const int i0 = 16 * wc + 4 * fq, pos = row & (SEQ - 1);
                    const f32x4 cs = *(const f32x4*)(cosT + pos * 32 + i0), sn = *(const f32x4*)(sinT + pos * 32 + i0);
                    const f32x4 x1 = acc[ai][0][m][0] * rs, x2 = acc[ai][0][m][1] * rs;
                    const f32x4 y1 = x1 * cs - x2 * sn, y2 = x2 * cs + x1 * sn;
                    u32x2 w; w.x = cvt_pk_bf16(y1[0], y1[1]); w.y = cvt_pk_bf16(y1[2], y1[3]); *(u32x2*)(KR + (size_t)row * 64 + i0) = w;
                    w.x = cvt_pk_bf16(y2[0], y2[1]); w.y = cvt_pk_bf16(y2[2], y2[3]); *(u32x2*)(KR + (size_t)row * 64 + 32 + i0) = w;
                }
            }
    }
};

template <class Epi, bool ALIGN_EPI>
__device__ __forceinline__ void gemm_phase(LAS unsigned char* lds, const Gemm g, const StaticOrder& S, const Epi& E) {
    int tid = threadIdx.x; asm volatile("" : "+v"(tid));
    const int wid = __builtin_amdgcn_readfirstlane(tid >> 6), lane = tid & 63, wr = wid >> 2, wc = wid & 3, fr = lane & 15, fq = lane >> 4;
    const int K = g.K, nt = K / BK;
    unsigned voffA[2], voffB[2];
#pragma unroll
    for (int i = 0; i < 2; ++i) { int R, C; stage_rc(tid * 16 + i * 8192, R, C); const int Rb = Epi::PERM ? ((R & ~31) + perm32(R & 31)) : R;
        voffA[i] = (unsigned)(R * g.lda + C) * 2u; voffB[i] = (unsigned)(Rb * g.ldb + C) * 2u; }
    const size_t kstep = (size_t)(BK * 2);
    const size_t hstepA = (size_t)HALF * g.lda * 2, hstepB = (size_t)HALF * g.ldb * 2;
    const size_t tstepA = 2 * hstepA, tstepB = 2 * hstepB;
    const unsigned ldsw = (unsigned)wid * 1024u;
    const int aoff = lds_byte(wr * 64 + fr, fq * 8), boff = lds_byte(wc * 32 + fr, fq * 8);
#define PG8_SA(b, h) (((b) * 2 + (h)) * HTB)
#define PG8_SB(b, h) ((4 + (b) * 2 + (h)) * HTB)
#define PG8_STAGE(bufoff, gbase, voff) do { _Pragma("unroll") for (int _i = 0; _i < 2; ++_i) \
        __builtin_amdgcn_global_load_lds((const unsigned*)((const char*)(gbase) + (voff)[_i]), (LAS unsigned*)(lds + (bufoff) + ldsw + _i * 8192), 16, 0, 0); } while (0)
#define PG8_LDA(dst, b, h) do { _Pragma("unroll") for (int m = 0; m < 4; ++m) _Pragma("unroll") for (int k = 0; k < 2; ++k) dst[m][k] = *(const LAS bf16x8*)(lds + PG8_SA(b, h) + aoff + m * 2048 + k * 1024); } while (0)
#define PG8_LDB(dst, b, h) do { _Pragma("unroll") for (int n = 0; n < 2; ++n) _Pragma("unroll") for (int k = 0; k < 2; ++k) dst[n][k] = *(const LAS bf16x8*)(lds + PG8_SB(b, h) + boff + n * 2048 + k * 1024); } while (0)
#define PG8_MMA(ai, bj, At, Bt) do { __builtin_amdgcn_s_setprio(1); _Pragma("unroll") for (int m = 0; m < 4; ++m) _Pragma("unroll") for (int n = 0; n < 2; ++n) _Pragma("unroll") for (int k = 0; k < 2; ++k) \
        acc[ai][bj][m][n] = __builtin_amdgcn_mfma_f32_16x16x32_bf16(Bt[n][k], At[m][k], acc[ai][bj][m][n], 0, 0, 0); __builtin_amdgcn_s_setprio(0); } while (0)
#define PG8_WAIT_V(n) asm volatile("s_waitcnt vmcnt(" #n ")" ::: "memory")
#define PG8_WAIT_L(n) asm volatile("s_waitcnt lgkmcnt(" #n ")" ::: "memory")
#define PG8_BAR __builtin_amdgcn_s_barrier()
#define PG8_SCHED __builtin_amdgcn_sched_barrier(0)
    Unit cur, nxt; int ui = 0;
    if (!S.next(0, cur)) return;
    f32x4 acc[2][2][4][2];
#pragma unroll
    for (int a = 0; a < 2; ++a)
#pragma unroll
        for (int b = 0; b < 2; ++b)
#pragma unroll
            for (int m = 0; m < 4; ++m)
#pragma unroll
                for (int n = 0; n < 2; ++n) acc[a][b][m][n] = (f32x4){0.f, 0.f, 0.f, 0.f};
    bf16x8 At[4][2], B0[2][2], B1[2][2];
    const char* cA = (const char*)g.A + (size_t)cur.pm * tstepA; const char* cB = (const char*)g.Bt + (size_t)cur.pn * tstepB;
    PG8_STAGE(PG8_SB(0, 0), cB, voffB); PG8_STAGE(PG8_SB(0, 1), cB + hstepB, voffB); PG8_STAGE(PG8_SA(0, 0), cA, voffA); PG8_STAGE(PG8_SA(0, 1), cA + hstepA, voffA);
    if (wr == 1) PG8_BAR;
    PG8_WAIT_V(2); PG8_BAR;
    PG8_STAGE(PG8_SB(1, 0), cB + kstep, voffB); PG8_STAGE(PG8_SA(1, 0), cA + kstep, voffA); PG8_STAGE(PG8_SB(1, 1), cB + hstepB + kstep, voffB);
    PG8_WAIT_V(6); PG8_BAR;
    for (;;) {
        const bool has_next = S.next(ui + 1, nxt);
        const char* nA = has_next ? (const char*)g.A + (size_t)nxt.pm * tstepA : cA; const char* nB = has_next ? (const char*)g.Bt + (size_t)nxt.pn * tstepB : cB;
        for (int t = 0; t < nt; t += 2) {
            const bool last = (t == nt - 2);
            const char* a1 = cA + (size_t)(t + 1) * kstep;
            const char* a2 = last ? nA : cA + (size_t)(t + 2) * kstep; const char* b2 = last ? nB : cB + (size_t)(t + 2) * kstep;
            const char* a3 = a2 + kstep; const char* b3 = b2 + kstep;
            PG8_LDB(B0, 0, 0); PG8_LDB(B1, 0, 1); PG8_SCHED; PG8_LDA(At, 0, 0); PG8_STAGE(PG8_SA(1, 1), a1 + hstepA, voffA);
            PG8_WAIT_V(8); PG8_WAIT_L(0); PG8_BAR; PG8_MMA(0, 0, At, B0); PG8_MMA(0, 1, At, B1); PG8_BAR; PG8_SCHED;
            PG8_LDA(At, 0, 1); PG8_STAGE(PG8_SB(0, 0), b2, voffB); PG8_STAGE(PG8_SB(0, 1), b2 + hstepB, voffB); PG8_STAGE(PG8_SA(0, 0), a2, voffA);
            PG8_WAIT_V(8); PG8_WAIT_L(0); PG8_BAR; PG8_MMA(1, 0, At, B0); PG8_MMA(1, 1, At, B1); PG8_BAR; PG8_SCHED;
            PG8_LDB(B0, 1, 0); PG8_LDB(B1, 1, 1); PG8_SCHED; PG8_LDA(At, 1, 0); PG8_STAGE(PG8_SA(0, 1), a2 + hstepA, voffA);
            PG8_WAIT_V(8); PG8_WAIT_L(0); PG8_BAR; PG8_MMA(0, 0, At, B0); PG8_MMA(0, 1, At, B1); PG8_BAR; PG8_SCHED;
            PG8_LDA(At, 1, 1); PG8_STAGE(PG8_SB(1, 0), b3, voffB); PG8_STAGE(PG8_SB(1, 1), b3 + hstepB, voffB); PG8_STAGE(PG8_SA(1, 0), a3, voffA);
            PG8_WAIT_V(8); PG8_WAIT_L(0); PG8_BAR; PG8_MMA(1, 0, At, B0); PG8_MMA(1, 1, At, B1); PG8_BAR; PG8_SCHED;
        }
        if constexpr (ALIGN_EPI) { if (wr == 0) PG8_BAR; }
        E(acc, cur, wr, wc, fr, fq);
        if (!has_next) break;
#pragma unroll
        for (int a = 0; a < 2; ++a)
#pragma unroll
            for (int b = 0; b < 2; ++b)
#pragma unroll
                for (int m = 0; m < 4; ++m)
#pragma unroll
                    for (int n = 0; n < 2; ++n) acc[a][b][m][n] = (f32x4){0.f, 0.f, 0.f, 0.f};
        cur = nxt; cA = nA; cB = nB; ++ui;
        if constexpr (ALIGN_EPI) { if (wr == 1) PG8_BAR; }
    }
    PG8_WAIT_V(0);
    if constexpr (!ALIGN_EPI) { if (wr == 0) PG8_BAR; }
    PG8_BAR;
#undef PG8_SA
#undef PG8_SB
#undef PG8_STAGE
#undef PG8_LDA
#undef PG8_LDB
#undef PG8_MMA
#undef PG8_WAIT_V
#undef PG8_WAIT_L
#undef PG8_BAR
#undef PG8_SCHED
}
}

struct AttnPtrs { const bf16_t* Q; int ldq, qoff; const bf16_t* K; int ldk, koff; const bf16_t* K2; int ldk2; const bf16_t* V; int ldv, voff; bf16_t* O; int ldo, ooff; };
template <int DQK, int DV, bool WIN>
__device__ __forceinline__ void attn_unit(LAS unsigned char* lds, const int b, const int qb, const AttnPtrs P, const float* cosT, const float* sinT, const float slope_l2, const float sink_l2) {
    constexpr int KP = DQK * 2 + 16, VP = DV * 2 + 64, KBUF = 64 * KP, VBUF = 64 * VP, BUF = KBUF + VBUF;
    constexpr int NKC = DQK / 8, NVC = DV / 8, KCH = 64 * NKC / 512, VCH = 64 * NVC / 512, ND0 = DQK / 16, NDB = DV / 32;
    constexpr int DK1 = WIN ? DQK : 128;
    static_assert(2 * BUF <= 131072, "attention LDS");
    int tid = threadIdx.x; asm volatile("" : "+v"(tid));
    const int lane = tid & 63, wid = __builtin_amdgcn_readfirstlane(tid >> 6), r32 = lane & 31, hi = lane >> 5;
    const long rowbase = (long)b * SEQ; const int q0 = qb * 256, qw = q0 + wid * 32, qabs = qw + r32;
    bf16x8 qr[ND0];
    { const bf16_t* qrow = P.Q + (size_t)(rowbase + qabs) * P.ldq + P.qoff;
#pragma unroll
      for (int d0 = 0; d0 < ND0; ++d0) qr[d0] = *(const bf16x8*)(qrow + 16 * d0 + 8 * hi);
      if constexpr (!WIN) {
#pragma unroll
          for (int dd = 0; dd < 2; ++dd) {
              const int i0 = 16 * dd + 8 * hi;
              const f32x4 c0 = *(const f32x4*)(cosT + qabs * 32 + i0), c1 = *(const f32x4*)(cosT + qabs * 32 + i0 + 4);
              const f32x4 s0 = *(const f32x4*)(sinT + qabs * 32 + i0), s1 = *(const f32x4*)(sinT + qabs * 32 + i0 + 4);
              bf16x8 a = qr[8 + dd], c = qr[10 + dd];
#pragma unroll
              for (int j = 0; j < 8; j += 2) {
                  const float cs0 = j < 4 ? c0[j] : c1[j - 4], cs1 = j < 4 ? c0[j + 1] : c1[j - 3], sn0 = j < 4 ? s0[j] : s1[j - 4], sn1 = j < 4 ? s0[j + 1] : s1[j - 3];
                  const float x10 = bf2f((unsigned short)a[j]), x11 = bf2f((unsigned short)a[j + 1]), x20 = bf2f((unsigned short)c[j]), x21 = bf2f((unsigned short)c[j + 1]);
                  const unsigned w1 = cvt_pk_bf16(x10 * cs0 - x20 * sn0, x11 * cs1 - x21 * sn1), w2 = cvt_pk_bf16(x20 * cs0 + x10 * sn0, x21 * cs1 + x11 * sn1);
                  a[j] = (short)(w1 & 0xffff); a[j + 1] = (short)(w1 >> 16); c[j] = (short)(w2 & 0xffff); c[j + 1] = (short)(w2 >> 16);
              }
              qr[8 + dd] = a; qr[10 + dd] = c;
          }
      }
    }
    const int t_begin = WIN ? ((q0 == 0) ? 2 : 0) : 0, t_end = WIN ? ((q0 + 256 == SEQ) ? 6 : 8) : (SEQ / 64);
    const int kt_lo = WIN ? (q0 - 128) : 0;
    float m_run = WIN ? sink_l2 : -INFINITY, l_run = (WIN && hi == 0) ? 1.f : 0.f;
    f32x16 oT[NDB];
#pragma unroll
    for (int i = 0; i < NDB; ++i) oT[i] = (f32x16){0.f, 0.f, 0.f, 0.f, 0.f, 0.f, 0.f, 0.f, 0.f, 0.f, 0.f, 0.f, 0.f, 0.f, 0.f, 0.f};
    u32x4 stK[KCH], stV[VCH];
    auto load_tile = [&](int t) __attribute__((always_inline)) {
        const int kt = kt_lo + 64 * t;
#pragma unroll
        for (int i = 0; i < KCH; ++i) { const int ck = tid + 512 * i, key = ck / NKC, c = ck % NKC; int ka = kt + key; if (WIN) ka = ka < 0 ? 0 : (ka > SEQ - 1 ? SEQ - 1 : ka);
            const bf16_t* src = (8 * c < DK1) ? P.K + (size_t)(rowbase + ka) * P.ldk + P.koff + 8 * c : P.K2 + (size_t)(rowbase + ka) * P.ldk2 + (8 * c - DK1);
            stK[i] = *(const u32x4*)src; }
#pragma unroll
        for (int i = 0; i < VCH; ++i) { const int cv = tid + 512 * i, key = cv / NVC, c = cv % NVC; int ka = kt + key; if (WIN) ka = ka < 0 ? 0 : (ka > SEQ - 1 ? SEQ - 1 : ka);
            stV[i] = *(const u32x4*)(P.V + (size_t)(rowbase + ka) * P.ldv + P.voff + 8 * c); }
    };
    auto store_tile = [&](int buf) __attribute__((always_inline)) {
        LAS unsigned char* kb = lds + buf * BUF; LAS unsigned char* vb = kb + KBUF;
#pragma unroll
        for (int i = 0; i < KCH; ++i) { const int ck = tid + 512 * i, key = ck / NKC, c = ck % NKC; *(LAS u32x4*)(kb + key * KP + c * 16) = stK[i]; }
#pragma unroll
        for (int i = 0; i < VCH; ++i) { const int cv = tid + 512 * i, key = cv / NVC, c = cv % NVC; *(LAS u32x4*)(vb + key * VP + c * 16) = stV[i]; }
    };
    load_tile(t_begin); store_tile(0);
    __syncthreads();
    const int vrd = (4 * hi + ((lane & 15) >> 2)) * VP + (16 * ((lane >> 4) & 1) + 4 * (lane & 3)) * 2;
    int buf = 0;
    for (int t = t_begin; t < t_end; ++t) {
        const bool more = (t + 1 < t_end);
        if (more) load_tile(t + 1);
        const int kt = kt_lo + 64 * t;
        bool active = true;
        if constexpr (WIN) active = (kt + 63 >= qw - 128) && (kt <= qw + 159);
        if (active) {
            LAS unsigned char* kb = lds + buf * BUF; LAS unsigned char* vb = kb + KBUF;
            f32x16 p0 = (f32x16){0.f, 0.f, 0.f, 0.f, 0.f, 0.f, 0.f, 0.f, 0.f, 0.f, 0.f, 0.f, 0.f, 0.f, 0.f, 0.f}, p1 = p0;
#pragma unroll
            for (int d0 = 0; d0 < ND0; ++d0) {
                const bf16x8 k0 = *(const LAS bf16x8*)(kb + r32 * KP + d0 * 32 + hi * 16);
                const bf16x8 k1 = *(const LAS bf16x8*)(kb + (32 + r32) * KP + d0 * 32 + hi * 16);
                p0 = __builtin_amdgcn_mfma_f32_32x32x16_bf16(k0, qr[d0], p0, 0, 0, 0);
                p1 = __builtin_amdgcn_mfma_f32_32x32x16_bf16(k1, qr[d0], p1, 0, 0, 0);
            }
            if constexpr (WIN) {
                const float relb = (float)(kt + 4 * hi - qabs);
#pragma unroll
                for (int r = 0; r < 16; ++r) {
                    const float x0 = relb + (float)((r & 3) + 8 * (r >> 2)), x1 = x0 + 32.f;
                    const float a0 = __builtin_fabsf(x0), a1 = __builtin_fabsf(x1);
                    p0[r] = (a0 <= 128.f) ? fmaf(-slope_l2, a0, p0[r]) : -INFINITY; p1[r] = (a1 <= 128.f) ? fmaf(-slope_l2, a1, p1[r]) : -INFINITY;
                }
            }
            float mx = fmaxf(p0[0], p1[0]);
#pragma unroll
            for (int r = 1; r < 16; ++r) mx = fmaxf(mx, fmaxf(p0[r], p1[r]));
            mx = fmaxf(mx, __shfl_xor(mx, 32));
            const float m_new = fmaxf(m_run, mx);
            const float alpha = __builtin_amdgcn_exp2f(m_run - m_new);
            float ps = 0.f;
#pragma unroll
            for (int r = 0; r < 16; ++r) { p0[r] = __builtin_amdgcn_exp2f(p0[r] - m_new); p1[r] = __builtin_amdgcn_exp2f(p1[r] - m_new); ps += p0[r] + p1[r]; }
            l_run = l_run * alpha + ps; m_run = m_new;
            if (__any(alpha != 1.f)) {
#pragma unroll
                for (int i = 0; i < NDB; ++i)
#pragma unroll
                    for (int r = 0; r < 16; ++r) oT[i][r] *= alpha;
            }
            bf16x8 pf[2][2];
#pragma unroll
            for (int s = 0; s < 2; ++s) {
                u32x4 w0, w1;
                w0.x = cvt_pk_bf16(p0[8 * s + 0], p0[8 * s + 1]); w0.y = cvt_pk_bf16(p0[8 * s + 2], p0[8 * s + 3]); w0.z = cvt_pk_bf16(p0[8 * s + 4], p0[8 * s + 5]); w0.w = cvt_pk_bf16(p0[8 * s + 6], p0[8 * s + 7]);
                w1.x = cvt_pk_bf16(p1[8 * s + 0], p1[8 * s + 1]); w1.y = cvt_pk_bf16(p1[8 * s + 2], p1[8 * s + 3]); w1.z = cvt_pk_bf16(p1[8 * s + 4], p1[8 * s + 5]); w1.w = cvt_pk_bf16(p1[8 * s + 6], p1[8 * s + 7]);
                pf[0][s] = __builtin_bit_cast(bf16x8, w0); pf[1][s] = __builtin_bit_cast(bf16x8, w1);
            }
#pragma unroll
            for (int db = 0; db < NDB; ++db)
#pragma unroll
                for (int kk = 0; kk < 2; ++kk)
#pragma unroll
                    for (int s = 0; s < 2; ++s) {
                        LAS unsigned char* vp = vb + vrd + (kk * 32 + 16 * s) * VP + db * 64;
                        const v4i16_t lo = __builtin_amdgcn_ds_read_tr16_b64_v4i16((LAS v4i16_t*)vp);
                        const v4i16_t hh = __builtin_amdgcn_ds_read_tr16_b64_v4i16((LAS v4i16_t*)(vp + 8 * VP));
                        const bf16x8 vf = (bf16x8){lo[0], lo[1], lo[2], lo[3], hh[0], hh[1], hh[2], hh[3]};
                        oT[db] = __builtin_amdgcn_mfma_f32_32x32x16_bf16(vf, pf[kk][s], oT[db], 0, 0, 0);
                    }
        }
        if (more) store_tile(buf ^ 1);
        __syncthreads();
        buf ^= 1;
    }
    const float lt = l_run + __shfl_xor(l_run, 32); const float inv = 1.f / lt;
    bf16_t* orow = P.O + (size_t)(rowbase + qabs) * P.ldo + P.ooff;
#pragma unroll
    for (int db = 0; db < NDB; ++db)
#pragma unroll
        for (int g4 = 0; g4 < 4; ++g4) {
            u32x2 w; w.x = cvt_pk_bf16(oT[db][4 * g4] * inv, oT[db][4 * g4 + 1] * inv); w.y = cvt_pk_bf16(oT[db][4 * g4 + 2] * inv, oT[db][4 * g4 + 3] * inv);
            *(u32x2*)(orow + 32 * db + 8 * g4 + 4 * hi) = w;
        }
}

struct Args { const float* in[27]; float* out; unsigned char* ws; };
enum { I_X = 0, I_MIXN, I_FFNN, I_FINN, I_AQKV, I_AWO, I_ASINK, I_SARE, I_SAIM, I_SLS, I_SBRE, I_SBIM, I_SCRE, I_SCIM, I_SD, I_SWGLU, I_SBGLU, I_MDQ, I_MQN, I_MKVN, I_MUQ, I_MUKV, I_MWO, I_FUP, I_FCW, I_FCB, I_FDOWN };

__device__ __forceinline__ void tr_item(const float* __restrict__ W, int K, int N, bf16_t* WT, const float* gain, int scale_n, float scale, bool ropeperm, LAS float* scr, int item, int lane) {
    const int nblk = N / 32, kb = item / nblk, nb = item % nblk, k0 = 64 * kb, n0 = 32 * nb;
    {
        f32x4 v[8]; const int n4 = (lane & 7) * 4;
#pragma unroll
        for (int i = 0; i < 8; ++i) v[i] = *(const f32x4*)(W + (size_t)(k0 + 8 * i + (lane >> 3)) * N + n0 + n4);
#pragma unroll
        for (int i = 0; i < 8; ++i) { const int kk = 8 * i + (lane >> 3); const float gk = gain ? gain[k0 + kk] : 1.f;
            scr[kk * 33 + n4] = v[i][0] * gk; scr[kk * 33 + n4 + 1] = v[i][1] * gk; scr[kk * 33 + n4 + 2] = v[i][2] * gk; scr[kk * 33 + n4 + 3] = v[i][3] * gk; }
    }
    asm volatile("s_waitcnt lgkmcnt(0)" ::: "memory");
    const int c = lane & 7;
#pragma unroll
    for (int j = 0; j < 4; ++j) { const int nl = (lane >> 3) + 8 * j, n = n0 + nl; const LAS float* s = scr + (8 * c) * 33 + nl;
        const float sc = (n < scale_n) ? scale : 1.f;
        u32x4 o; o.x = cvt_pk_bf16(s[0 * 33] * sc, s[1 * 33] * sc); o.y = cvt_pk_bf16(s[2 * 33] * sc, s[3 * 33] * sc); o.z = cvt_pk_bf16(s[4 * 33] * sc, s[5 * 33] * sc); o.w = cvt_pk_bf16(s[6 * 33] * sc, s[7 * 33] * sc);
        int row = n;
        if (ropeperm && n >= 1024) { const int dim = n - 1024; row = 1024 + 32 * ((dim & 31) >> 4) + 16 * (dim >> 5) + (dim & 15); }
        *(u32x4*)(WT + (size_t)row * K + k0 + 8 * c) = o; }
    asm volatile("s_waitcnt lgkmcnt(0)" ::: "memory");
}

#define FRESH_IDS() int tid = threadIdx.x; asm volatile("" : "+v"(tid)); const int lane = tid & 63, wave = __builtin_amdgcn_readfirstlane(tid >> 6); \
    const int G = gridDim.x, bx = blockIdx.x; const int gw = bx * 8 + wave, NGW = G * 8; const size_t gt = (size_t)bx * 512 + tid, NGT = (size_t)G * 512; \
    unsigned char* ws = args.ws; asm volatile("" : "+s"(ws)); (void)lane; (void)wave; (void)gw; (void)NGW; (void)gt; (void)NGT; (void)G; (void)bx
#define SSQ(i) ((float*)(ws + WS_SSQP) + (size_t)(i) * T * 32)

__device__ __forceinline__ void phase_prologue(const Args& args, LAS unsigned char* lds) {
    FRESH_IDS();
    LAS float* scr = (LAS float*)(lds + wave * 16384);
    const float SC_A = 0.125f * LOG2E, SC_M = 0.07216878364870322f * LOG2E;
#define CONV(Wp, K_, N_, dst, gain_, sn, sc, rp) do { const int nit = ((K_) / 64) * ((N_) / 32); for (int it = gw; it < nit; it += NGW) tr_item((Wp), (K_), (N_), (bf16_t*)(ws + (dst)), (gain_), (sn), (sc), (rp), scr, it, lane); } while (0)
    CONV(args.in[I_AQKV], D, NQKV, W_QKV0, args.in[I_MIXN] + 0 * D, 2048, SC_A, false);
    CONV(args.in[I_AQKV] + (size_t)D * NQKV, D, NQKV, W_QKV1, args.in[I_MIXN] + 3 * D, 2048, SC_A, false);
    CONV(args.in[I_AWO], D, D, W_WO0, nullptr, 0, 1.f, false);
    CONV(args.in[I_AWO] + (size_t)D * D, D, D, W_WO1, nullptr, 0, 1.f, false);
    CONV(args.in[I_SWGLU], D, D, W_GLU, nullptr, 0, 1.f, false);
    CONV(args.in[I_MDQ], D, 1088, W_DQ, args.in[I_MIXN] + 2 * D, 0, 1.f, true);
    CONV(args.in[I_MUQ], 512, NUQ, W_UQ, args.in[I_MQN], NUQ, SC_M, false);
    CONV(args.in[I_MUKV], 512, NUKV, W_UKV, args.in[I_MKVN], 0, 1.f, false);
    CONV(args.in[I_MWO], D, D, W_MWO, nullptr, 0, 1.f, false);
#pragma unroll 1
    for (int l = 0; l < 4; ++l) {
        CONV(args.in[I_FUP] + (size_t)l * D * NUP, D, NUP, W_UP + (size_t)l * 44 * MiB, args.in[I_FFNN] + l * D, 0, 1.f, false);
        CONV(args.in[I_FDOWN] + (size_t)l * DFF * D, DFF, D, W_DOWN + (size_t)l * 22 * MiB, nullptr, 0, 1.f, false);
    }
#undef CONV
    { u32x4* z = (u32x4*)(ws + W_DQ + (size_t)1088 * D * 2); const size_t n16 = (size_t)(NDQ - 1088) * D * 2 / 16; for (size_t i = gt; i < n16; i += NGT) z[i] = (u32x4){0u, 0u, 0u, 0u}; }
    const float* xin = args.in[I_X]; bf16_t* XB = (bf16_t*)(ws + WS_XB); float* ssq = SSQ(0);
    for (int row = gw; row < T; row += NGW) {
        const f32x4* xr = (const f32x4*)(xin + (size_t)row * D) + lane; u32x2* o8 = (u32x2*)(XB + (size_t)row * D) + lane; float s = 0.f;
#pragma unroll
        for (int j = 0; j < 8; ++j) { const f32x4 v = xr[64 * j]; s += (v[0] * v[0] + v[1] * v[1]) + (v[2] * v[2] + v[3] * v[3]); u32x2 w; w.x = cvt_pk_bf16(v[0], v[1]); w.y = cvt_pk_bf16(v[2], v[3]); o8[64 * j] = w; }
        s = wave_sum(s); if (lane < 32) ssq[ssq_at(row, lane >> 2) + (lane & 3)] = (lane == 0) ? s : 0.f;
    }
    float* cosT = (float*)(ws + WS_ROPE); float* sinT = cosT + SEQ * 32;
    for (size_t i = gt; i < (size_t)SEQ * 32; i += NGT) {
        const int pos = (int)(i >> 5), fi = (int)(i & 31);
        const double inv = exp_d(-(double)fi * (9.210340371976184 / 32.0)); double s, c; sincos_d((double)pos * inv, s, c);
        cosT[i] = (float)c; sinT[i] = (float)s;
    }
    float* s5p = (float*)(ws + WS_S5P);
    for (size_t pidx = gt; pidx < (size_t)2 * 128 * 64; pidx += NGT) {
        const double are = (double)args.in[I_SARE][pidx], aim = (double)args.in[I_SAIM][pidx];
        const double step = exp_d((double)args.in[I_SLS][pidx >> 6]);
        const double mag = exp_d(step * are); double sn, cs; sincos_d(step * aim, sn, cs);
        const double lr = mag * cs, li = mag * sn, nre = lr - 1.0, nim = li, den = are * are + aim * aim;
        const double cre = (nre * are + nim * aim) / den, cim = (nim * are - nre * aim) / den;
        float* o = s5p + pidx * 64; o[0] = (float)lr; o[1] = (float)li; o[2] = 0.f; o[3] = 0.f;
        const float* bre = args.in[I_SBRE] + pidx * 16; const float* bim = args.in[I_SBIM] + pidx * 16;
        for (int c = 0; c < 16; ++c) { const double br = (double)bre[c], bi = (double)bim[c]; o[4 + c] = (float)(cre * br - cim * bi); o[20 + c] = (float)(cre * bi + cim * br); }
    }
}

__device__ __forceinline__ void phase_gemm_scale(const Args& args, LAS unsigned char* lds, size_t a_off, int lda, size_t w_off, int N, int K, size_t o_off, int ssq_idx, float inv_dim, bool np8) {
    unsigned char* ws = args.ws; asm volatile("" : "+s"(ws));
    pg8::Gemm g{(const bf16_t*)(ws + a_off), (const bf16_t*)(ws + w_off), T, N, K, lda, K}; pg8::StaticOrder S; S.init(T, N, gridDim.x, blockIdx.x);
    pg8::EpiScaleBf16 E{(bf16_t*)(ws + o_off), N, SSQ(ssq_idx), inv_dim, np8};
    pg8::gemm_phase<pg8::EpiScaleBf16, true>(lds, g, S, E);
}
__device__ __forceinline__ void phase_gemm_resid(const Args& args, LAS unsigned char* lds, size_t a_off, size_t w_off, int K, const float* Xin, int ssq_out, bool glu) {
    unsigned char* ws = args.ws; asm volatile("" : "+s"(ws));
    pg8::Gemm g{(const bf16_t*)(ws + a_off), (const bf16_t*)(ws + w_off), T, D, K, K, K}; pg8::StaticOrder S; S.init(T, D, gridDim.x, blockIdx.x);
    pg8::EpiResidual E{Xin, args.out, (bf16_t*)(ws + WS_XB), SSQ(ssq_out), glu ? (const bf16_t*)(ws + WS_OB) : nullptr, args.in[I_SBGLU]};
    pg8::gemm_phase<pg8::EpiResidual, true>(lds, g, S, E);
}
__device__ __forceinline__ void phase_dqkv(const Args& args, LAS unsigned char* lds, int ssq_in) {
    unsigned char* ws = args.ws; asm volatile("" : "+s"(ws));
    pg8::Gemm g{(const bf16_t*)(ws + WS_XB), (const bf16_t*)(ws + W_DQ), T, NDQ, D, D, D}; pg8::StaticOrder S; S.init(T, NDQ, gridDim.x, blockIdx.x);
    float* cosT = (float*)(ws + WS_ROPE);
    pg8::EpiDqkv E{(bf16_t*)(ws + WS_CQ), (bf16_t*)(ws + WS_CKV), (bf16_t*)(ws + WS_KR), SSQ(ssq_in), SSQ(9), SSQ(10), cosT, cosT + SEQ * 32};
    pg8::gemm_phase<pg8::EpiDqkv, true>(lds, g, S, E);
}
__device__ __forceinline__ void phase_conv(const Args& args, int l) {
    FRESH_IDS();
    const bf16_t* U = (const bf16_t*)(ws + WS_U); bf16_t* ACT = (bf16_t*)(ws + WS_ACT);
    const float* cw = args.in[I_FCW] + (size_t)l * 3 * NUP; const float* cb = args.in[I_FCB] + (size_t)l * NUP;
    constexpr int TT = 32, NCC = DFF / 8; const size_t total = (size_t)(T / TT) * NCC;
    for (size_t idx = gt; idx < total; idx += NGT) {
        const int cc = (int)(idx % NCC), tb = (int)(idx / NCC), t0 = tb * TT, j0 = cc * 8;
        float wg[3][8], wv[3][8], bg[8], bv[8];
#pragma unroll
        for (int k = 0; k < 3; ++k)
#pragma unroll
            for (int e = 0; e < 8; e += 4) { const f32x4 a = *(const f32x4*)(cw + (size_t)k * NUP + j0 + e), b2 = *(const f32x4*)(cw + (size_t)k * NUP + DFF + j0 + e);
                wg[k][e] = a[0]; wg[k][e + 1] = a[1]; wg[k][e + 2] = a[2]; wg[k][e + 3] = a[3]; wv[k][e] = b2[0]; wv[k][e + 1] = b2[1]; wv[k][e + 2] = b2[2]; wv[k][e + 3] = b2[3]; }
#pragma unroll
        for (int e = 0; e < 8; e += 4) { const f32x4 a = *(const f32x4*)(cb + j0 + e), b2 = *(const f32x4*)(cb + DFF + j0 + e);
            bg[e] = a[0]; bg[e + 1] = a[1]; bg[e + 2] = a[2]; bg[e + 3] = a[3]; bv[e] = b2[0]; bv[e + 1] = b2[1]; bv[e + 2] = b2[2]; bv[e + 3] = b2[3]; }
        const u32x4 zero4 = (u32x4){0u, 0u, 0u, 0u};
        u32x4 pg = ((t0 & (SEQ - 1)) == 0) ? zero4 : *(const u32x4*)(U + (size_t)(t0 - 1) * NUP + j0);
        u32x4 pv = ((t0 & (SEQ - 1)) == 0) ? zero4 : *(const u32x4*)(U + (size_t)(t0 - 1) * NUP + DFF + j0);
        u32x4 cg_ = *(const u32x4*)(U + (size_t)t0 * NUP + j0), cv = *(const u32x4*)(U + (size_t)t0 * NUP + DFF + j0);
#pragma unroll 2
        for (int t = t0; t < t0 + TT; ++t) {
            const bool edge = (((t + 1) & (SEQ - 1)) == 0);
            const u32x4 ng = edge ? zero4 : *(const u32x4*)(U + (size_t)(t + 1) * NUP + j0);
            const u32x4 nv = edge ? zero4 : *(const u32x4*)(U + (size_t)(t + 1) * NUP + DFF + j0);
            float r[8];
#pragma unroll
            for (int e2 = 0; e2 < 4; ++e2) {
#pragma unroll
                for (int hh = 0; hh < 2; ++hh) {
                    const int e = 2 * e2 + hh;
                    const float g0 = hh ? bfhi(pg[e2]) : bflo(pg[e2]), g1 = hh ? bfhi(cg_[e2]) : bflo(cg_[e2]), g2 = hh ? bfhi(ng[e2]) : bflo(ng[e2]);
                    const float v0 = hh ? bfhi(pv[e2]) : bflo(pv[e2]), v1 = hh ? bfhi(cv[e2]) : bflo(cv[e2]), v2 = hh ? bfhi(nv[e2]) : bflo(nv[e2]);
                    const float gg = bg[e] + wg[0][e] * g0 + wg[1][e] * g1 + wg[2][e] * g2;
                    const float vv = bv[e] + wv[0][e] * v0 + wv[1][e] * v1 + wv[2][e] * v2;
                    r[e] = gg * __builtin_amdgcn_rcpf(1.f + __expf(-gg)) * vv;
                }
            }
            u32x4 o; o.x = cvt_pk_bf16(r[0], r[1]); o.y = cvt_pk_bf16(r[2], r[3]); o.z = cvt_pk_bf16(r[4], r[5]); o.w = cvt_pk_bf16(r[6], r[7]);
            *(u32x4*)(ACT + (size_t)t * DFF + j0) = o;
            pg = cg_; pv = cv; cg_ = ng; cv = nv;
        }
    }
}
__device__ __forceinline__ void phase_attn_win(const Args& args, LAS unsigned char* lds, int j) {
    unsigned char* ws = args.ws; asm volatile("" : "+s"(ws));
    const bf16_t* QKV = (const bf16_t*)(ws + WS_QKV); bf16_t* OB = (bf16_t*)(ws + WS_OB);
    const float* sink = args.in[I_ASINK] + j * 32; const int G = gridDim.x;
    for (int u = blockIdx.x; u < 2048; u += G) {
        const int h = u & 31, qb = (u >> 5) & 31, b = u >> 10;
        const AttnPtrs P{QKV, NQKV, h * 64, QKV, NQKV, 2048 + (h >> 3) * 64, nullptr, 0, QKV, NQKV, 2304 + (h >> 3) * 64, OB, D, h * 64};
        const float slope = exp2f(-0.25f * (float)(h + 1)) * LOG2E;
        attn_unit<64, 64, true>(lds, b, qb, P, nullptr, nullptr, slope, sink[h] * LOG2E);
    }
}
__device__ __forceinline__ void phase_attn_mla(const Args& args, LAS unsigned char* lds) {
    unsigned char* ws = args.ws; asm volatile("" : "+s"(ws));
    const bf16_t* QM = (const bf16_t*)(ws + WS_Q); const bf16_t* KVM = (const bf16_t*)(ws + WS_KV); const bf16_t* KR = (const bf16_t*)(ws + WS_KR); bf16_t* OB = (bf16_t*)(ws + WS_OB);
    const float* cosT = (const float*)(ws + WS_ROPE); const float* sinT = cosT + SEQ * 32;
    const int G = gridDim.x, bx = blockIdx.x;
    for (int u = bx; u < 1024; u += G) {
        int bh, qb;
        if (G == 256) { bh = (bx & 7) * 4 + (u >> 8); qb = bx >> 3; } else { bh = u >> 5; qb = u & 31; }
        const int b = bh >> 4, h = bh & 15;
        const AttnPtrs P{QM, NUQ, h * 192, KVM, NUKV, h * 256, KR, 64, KVM, NUKV, h * 256 + 128, OB, D, h * 128};
        attn_unit<192, 128, false>(lds, b, qb, P, cosT, sinT, 0.f, 0.f);
    }
}
__device__ __forceinline__ void phase_s5(const Args& args, LAS unsigned char* lds, int ssq_idx) {
    FRESH_IDS();
    const float* X = args.out;
    constexpr int XP = 132, CH = 16, NCH = SEQ / CH, SEGC = NCH / 4;
    LAS float* hbuf = (LAS float*)(lds + wave * 9728);
    LAS float* Xs = hbuf + 256;
    LAS float* Sst = (LAS float*)(lds + 8 * 9728);
    const int fr = lane & 15, fq = lane >> 4, part = lane & 3, tlq = lane >> 2;
    const float* ssq_in = SSQ(ssq_idx);
    for (int pair = bx; pair < 256; pair += G) {
        const int seq = pair * 2 + (wave >> 2), seg = wave & 3;
        const int g = seq & 127, dir = (seq >> 7) & 1, b = seq >> 8;
        const size_t pidx = (size_t)(dir * 128 + g) * 64 + lane;
        float lbr, lbi; bf16x8 Bh[8];
        {
            const float* spb = (const float*)(ws + WS_S5P) + (size_t)(dir * 128 + g) * 64 * 64;
            const f32x4 l4 = *(const f32x4*)(spb + lane * 64); lbr = l4[0]; lbi = l4[1];
#pragma unroll
            for (int nt = 0; nt < 8; ++nt) {
                const float* p = spb + (16 * (nt & 3) + fr) * 64 + (nt < 4 ? 4 : 20) + 8 * (fq & 1);
                const f32x4 a = *(const f32x4*)p, b2 = *(const f32x4*)(p + 4);
                u32x4 w; w.x = cvt_pk_bf16(a[0], a[1]); w.y = cvt_pk_bf16(a[2], a[3]); w.z = cvt_pk_bf16(b2[0], b2[1]); w.w = cvt_pk_bf16(b2[2], b2[3]);
                if (fq >= 2) w = (u32x4){0u, 0u, 0u, 0u};
                Bh[nt] = __builtin_bit_cast(bf16x8, w);
            }
        }
        const f32x4 gain4 = *(const f32x4*)(args.in[I_MIXN] + 1 * D + g * 16 + part * 4);
        const size_t rowb = (size_t)b * SEQ;
        float xr = 0.f, xi = 0.f;
        f32x4 nv, npa, npb;
#define S5_LOAD(cidx) do { const int c0_ = dir ? (NCH - 1 - (cidx)) : (cidx); const size_t row_ = rowb + (size_t)c0_ * CH + tlq; \
            nv = *(const f32x4*)(X + row_ * D + g * 16 + part * 4); npa = *(const f32x4*)(ssq_in + ssq_at((int)row_, 2 * part)); npb = *(const f32x4*)(ssq_in + ssq_at((int)row_, 2 * part + 1)); } while (0)
#define S5_STAGE() do { float sq_ = ((npa[0] + npa[1]) + (npa[2] + npa[3])) + ((npb[0] + npb[1]) + (npb[2] + npb[3])); sq_ += __shfl_xor(sq_, 1); sq_ += __shfl_xor(sq_, 2); \
            const float rs_ = __builtin_amdgcn_rsqf(sq_ * (1.f / D) + EPS); *(LAS f32x4*)(hbuf + tlq * 16 + part * 4) = nv * rs_ * gain4; } while (0)
#define S5_BU() do {   \
            const f32x4 h0_ = *(const LAS f32x4*)(hbuf + fr * 16 + 8 * (fq & 1)), h1_ = *(const LAS f32x4*)(hbuf + fr * 16 + 8 * (fq & 1) + 4); \
            bf16x8 ah_, al_; split_bf16x8(h0_, h1_, ah_, al_); \
            if (fq >= 2) { ah_ = (bf16x8){0, 0, 0, 0, 0, 0, 0, 0}; al_ = ah_; } \
            _Pragma("unroll") for (int nt = 0; nt < 8; ++nt) { f32x4 d_ = (f32x4){0.f, 0.f, 0.f, 0.f}; \
                d_ = __builtin_amdgcn_mfma_f32_16x16x32_bf16(ah_, Bh[nt], d_, 0, 0, 0); \
                _Pragma("unroll") for (int r_ = 0; r_ < 4; ++r_) Xs[(4 * fq + r_) * XP + 16 * nt + fr] = d_[r_]; } } while (0)
#define S5_STEP(tl, STORE) do { \
            const float bur = Xs[(tl) * XP + lane], bui = Xs[(tl) * XP + 64 + lane]; \
            const float nxr = fmaf(lbr, xr, fmaf(-lbi, xi, bur)), nxi = fmaf(lbr, xi, fmaf(lbi, xr, bui)); xr = nxr; xi = nxi; \
            if (STORE) { Xs[(tl) * XP + lane] = xr; Xs[(tl) * XP + 64 + lane] = xi; } } while (0)
        const int cbeg = seg * SEGC, cend = cbeg + SEGC;
        S5_LOAD(cbeg);
#pragma unroll 1
        for (int ci = cbeg; ci < cend; ++ci) {
            S5_STAGE();
            if (ci + 1 < cend) S5_LOAD(ci + 1);
            asm volatile("s_waitcnt lgkmcnt(0)" ::: "memory");
            S5_BU();
            asm volatile("s_waitcnt lgkmcnt(0)" ::: "memory");
#pragma unroll 4
            for (int i = 0; i < CH; ++i) { const int tl = dir ? CH - 1 - i : i; S5_STEP(tl, false); }
            asm volatile("s_waitcnt lgkmcnt(0)" ::: "memory");
        }
        Sst[wave * 128 + lane] = xr; Sst[wave * 128 + 64 + lane] = xi;
        __syncthreads();
        {
            float pr = lbr, pi = lbi;
#pragma unroll
            for (int k = 0; k < 11; ++k) { const float nr = pr * pr - pi * pi, ni = 2.f * pr * pi; pr = nr; pi = ni; }
            xr = 0.f; xi = 0.f;
            for (int j = 0; j < seg; ++j) { const float sr = Sst[((wave & ~3) + j) * 128 + lane], si = Sst[((wave & ~3) + j) * 128 + 64 + lane];
                const float nr = fmaf(pr, xr, fmaf(-pi, xi, sr)), ni = fmaf(pr, xi, fmaf(pi, xr, si)); xr = nr; xi = ni; }
        }
        bf16x8 Ch[4];
        {
            const float* cre_p = args.in[I_SCRE] + ((size_t)(dir * 128 + g) * 16 + fr) * 64; const float* cim_p = args.in[I_SCIM] + ((size_t)(dir * 128 + g) * 16 + fr) * 64;
#pragma unroll
            for (int kk = 0; kk < 4; ++kk) {
                const float* p = (kk < 2 ? cre_p + 32 * kk : cim_p + 32 * (kk - 2)) + 8 * fq; const float sg = (kk < 2) ? 1.f : -1.f;
                const f32x4 a = *(const f32x4*)p * sg, b2 = *(const f32x4*)(p + 4) * sg;
                u32x4 w; w.x = cvt_pk_bf16(a[0], a[1]); w.y = cvt_pk_bf16(a[2], a[3]); w.z = cvt_pk_bf16(b2[0], b2[1]); w.w = cvt_pk_bf16(b2[2], b2[3]);
                Ch[kk] = __builtin_bit_cast(bf16x8, w);
            }
        }
        const float dsk = args.in[I_SD][g * 16 + fr];
        float* Y = (float*)(ws + (dir ? WS_YR : WS_YF));
        S5_LOAD(cbeg);
#pragma unroll 1
        for (int ci = cbeg; ci < cend; ++ci) {
            S5_STAGE();
            if (ci + 1 < cend) S5_LOAD(ci + 1);
            asm volatile("s_waitcnt lgkmcnt(0)" ::: "memory");
            S5_BU();
            asm volatile("s_waitcnt lgkmcnt(0)" ::: "memory");
#pragma unroll 4
            for (int i = 0; i < CH; ++i) { const int tl = dir ? CH - 1 - i : i; S5_STEP(tl, true); }
            asm volatile("s_waitcnt lgkmcnt(0)" ::: "memory");
            f32x4 acc = (f32x4){0.f, 0.f, 0.f, 0.f};
#pragma unroll
            for (int kk = 0; kk < 4; ++kk) {
                const f32x4 x0 = *(const LAS f32x4*)(Xs + fr * XP + 32 * kk + 8 * fq), x1 = *(const LAS f32x4*)(Xs + fr * XP + 32 * kk + 8 * fq + 4);
                bf16x8 xh, xl; split_bf16x8(x0, x1, xh, xl);
                acc = __builtin_amdgcn_mfma_f32_16x16x32_bf16(xh, Ch[kk], acc, 0, 0, 0);
            }
            const int c0 = dir ? (NCH - 1 - ci) : ci; const size_t tbase = rowb + (size_t)c0 * CH;
#pragma unroll
            for (int jj = 0; jj < 4; ++jj) {
                const int tl = 4 * fq + jj; float val = acc[jj];
                if (dir == 0) val += dsk * hbuf[tl * 16 + fr];
                Y[(tbase + tl) * D + g * 16 + fr] = val;
            }
            asm volatile("s_waitcnt lgkmcnt(0)" ::: "memory");
        }
        __syncthreads();
#undef S5_LOAD
#undef S5_STAGE
#undef S5_STEP
#undef S5_BU
    }
}
__device__ __forceinline__ void phase_gelu(const Args& args) {
    FRESH_IDS();
    const f32x4* YF = (const f32x4*)(ws + WS_YF); const f32x4* YR = (const f32x4*)(ws + WS_YR); u32x2* OB = (u32x2*)(ws + WS_OB);
    for (size_t i = gt; i < (size_t)T * D / 4; i += NGT) {
        const f32x4 a = YF[i], c = YR[i]; float z[4];
#pragma unroll
        for (int e = 0; e < 4; ++e) { const float y = a[e] + c[e]; const float u2 = 1.5957691216057308f * (y + 0.044715f * y * y * y); z[e] = y * __builtin_amdgcn_rcpf(1.f + __expf(-u2)); }
        u32x2 w; w.x = cvt_pk_bf16(z[0], z[1]); w.y = cvt_pk_bf16(z[2], z[3]); OB[i] = w;
    }
}
__device__ __forceinline__ void phase_final(const Args& args) {
    FRESH_IDS();
    const float* ssq_f = SSQ(8); const float* gf = args.in[I_FINN]; float* X = args.out;
    for (int row = gw; row < T; row += NGW) {
        const float rs = __builtin_amdgcn_rsqf(wave_sum(lane < 32 ? ssq_f[ssq_at(row, lane >> 2) + (lane & 3)] : 0.f) * (1.f / D) + EPS);
        f32x4* xr = (f32x4*)(X + (size_t)row * D) + lane; const f32x4* gr = (const f32x4*)gf + lane;
#pragma unroll
        for (int j = 0; j < 8; ++j) { f32x4 v = xr[64 * j]; v = v * rs * gr[64 * j]; xr[64 * j] = v; }
    }
}

__device__ __forceinline__ void my_barrier(unsigned* cnt, unsigned target) {
    __syncthreads();
    if (threadIdx.x == 0) {
        __builtin_amdgcn_fence(__ATOMIC_RELEASE, "agent"); asm volatile("s_waitcnt vmcnt(0) lgkmcnt(0)" ::: "memory");
        __hip_atomic_fetch_add(cnt, 1u, __ATOMIC_RELAXED, __HIP_MEMORY_SCOPE_AGENT);
        while (__hip_atomic_load(cnt, __ATOMIC_RELAXED, __HIP_MEMORY_SCOPE_AGENT) < target) __builtin_amdgcn_s_sleep(2);
        __builtin_amdgcn_fence(__ATOMIC_ACQUIRE, "agent"); asm volatile("s_waitcnt vmcnt(0)" ::: "memory");
    }
    __syncthreads();
}
__global__ void __launch_bounds__(512, 2) fwd_kernel(Args args) {
    extern __shared__ __attribute__((aligned(16))) unsigned char lds_raw[];
    LAS unsigned char* lds = (LAS unsigned char*)lds_raw;
    cg::grid_group grid = cg::this_grid();
    unsigned nbar = 0;
    if (blockIdx.x == 0 && threadIdx.x == 0) __hip_atomic_store((unsigned*)(args.ws + WS_BAR), 0u, __ATOMIC_RELEASE, __HIP_MEMORY_SCOPE_AGENT);
#define GRID_SYNC() do { asm volatile("s_waitcnt vmcnt(0) lgkmcnt(0)" ::: "memory"); if (nbar == 0) grid.sync(); my_barrier((unsigned*)(args.ws + WS_BAR), (++nbar) * gridDim.x); } while (0)
    GRID_SYNC();
    phase_prologue(args, lds);
    GRID_SYNC();
#pragma unroll 1
    for (int l = 0; l < 4; ++l) {
        const int kind = l % 3, j = l / 3;
        size_t w_o;
        if (kind == 0) {
            phase_gemm_scale(args, lds, WS_XB, D, j ? W_QKV1 : W_QKV0, NQKV, D, WS_QKV, 2 * l, 1.f / D, false);
            GRID_SYNC();
            phase_attn_win(args, lds, j);
            w_o = j ? W_WO1 : W_WO0;
        } else if (kind == 1) {
            phase_s5(args, lds, 2 * l);
            GRID_SYNC();
            phase_gelu(args);
            w_o = W_GLU;
        } else {
            phase_dqkv(args, lds, 2 * l);
            GRID_SYNC();
            phase_gemm_scale(args, lds, WS_CQ, 512, W_UQ, NUQ, 512, WS_Q, 9, 1.f / 512, true);
            phase_gemm_scale(args, lds, WS_CKV, 512, W_UKV, NUKV, 512, WS_KV, 10, 1.f / 512, true);
            GRID_SYNC();
            phase_attn_mla(args, lds);
            w_o = W_MWO;
        }
        GRID_SYNC();
        phase_gemm_resid(args, lds, WS_OB, w_o, D, l == 0 ? args.in[I_X] : args.out, 2 * l + 1, kind == 1);
        GRID_SYNC();
        phase_gemm_scale(args, lds, WS_XB, D, W_UP + (size_t)l * 44 * MiB, NUP, D, WS_U, 2 * l + 1, 1.f / D, false);
        GRID_SYNC();
        phase_conv(args, l);
        GRID_SYNC();
        phase_gemm_resid(args, lds, WS_ACT, W_DOWN + (size_t)l * 22 * MiB, DFF, args.out, 2 * l + 2, false);
        GRID_SYNC();
    }
    phase_final(args);
}

extern "C" void kernel_launch(void* const* d_in, const int* in_sizes, int n_in, void* d_out, int out_size, void* d_ws, size_t ws_size, hipStream_t stream) {
    static int grid = 0;
    if (grid == 0) {
        if (n_in != 27 || out_size != T * D || ws_size < WS_END) { fprintf(stderr, "kernel_launch: unexpected problem (n_in %d out %d ws %zu need %zu)\n", n_in, out_size, ws_size, (size_t)WS_END); grid = -1; return; }
        int dev = 0, cus = 0, per_cu = 0;
        (void)hipGetDevice(&dev);
        (void)hipDeviceGetAttribute(&cus, hipDeviceAttributeMultiprocessorCount, dev);
        (void)hipFuncSetAttribute((const void*)fwd_kernel, hipFuncAttributeMaxDynamicSharedMemorySize, LDS_BYTES);
        (void)hipOccupancyMaxActiveBlocksPerMultiprocessor(&per_cu, (const void*)fwd_kernel, 512, LDS_BYTES);
        if (per_cu < 1) per_cu = 1;
        grid = cus * per_cu;
        (void)hipGetLastError();
    }
    if (grid < 0) return;
    (void)hipMemsetAsync(d_ws, 0, 256, stream);
    Args a{};
    for (int i = 0; i < 27; ++i) a.in[i] = (const float*)d_in[i];
    a.out = (float*)d_out; a.ws = (unsigned char*)d_ws;
    void* kargs[] = {&a};
    hipError_t e = hipLaunchCooperativeKernel((void*)fwd_kernel, dim3(grid), dim3(512), kargs, LDS_BYTES, stream);
    if (e != hipSuccess) fprintf(stderr, "cooperative launch failed: %s (grid %d)\n", hipGetErrorString(e), grid);
}
```

```cpp
#include <hip/hip_runtime.h>
#include <hip/hip_cooperative_groups.h>
#include <cstdio>
#include <cstdint>
namespace cg = cooperative_groups;

#define LAS __attribute__((address_space(3)))
typedef unsigned short bf16_t;
typedef short bf16x8 __attribute__((ext_vector_type(8)));
typedef short v4i16_t __attribute__((ext_vector_type(4)));
typedef float f32x4 __attribute__((ext_vector_type(4)));
typedef float f32x16 __attribute__((ext_vector_type(16)));
typedef unsigned u32x4 __attribute__((ext_vector_type(4)));
typedef unsigned u32x2 __attribute__((ext_vector_type(2)));

constexpr int SEQ = 8192, BATCH = 2, T = BATCH * SEQ, D = 2048, DFF = 5632, NUP = 2 * DFF;
constexpr int NQKV = 2560, NDQ = 1280  , NUQ = 3072, NUKV = 4096;
constexpr float EPS = 1e-6f;
constexpr float LOG2E = 1.4426950408889634f;

constexpr size_t MiB = 1u << 20;
constexpr size_t WS_BAR = 0;
constexpr size_t WS_ROPE = 1 * MiB;
constexpr size_t WS_KR = 3 * MiB;
constexpr size_t WS_W = 8 * MiB;
constexpr size_t W_QKV0 = WS_W, W_QKV1 = W_QKV0 + 10 * MiB, W_WO0 = W_QKV1 + 10 * MiB, W_WO1 = W_WO0 + 8 * MiB, W_GLU = W_WO1 + 8 * MiB;
constexpr size_t W_DQ = W_GLU + 8 * MiB, W_UQ = W_DQ + 5 * MiB, W_UKV = W_UQ + 3 * MiB, W_MWO = W_UKV + 4 * MiB;
constexpr size_t W_UP = W_MWO + 8 * MiB;
constexpr size_t W_DOWN = W_UP + 176 * MiB;
constexpr size_t WS_XB = W_DOWN + 88 * MiB;
constexpr size_t WS_OB = WS_XB + 64 * MiB;
constexpr size_t WS_QKV = WS_OB + 64 * MiB;
constexpr size_t WS_CQ = WS_QKV, WS_CKV = WS_CQ + 16 * MiB, WS_Q = WS_CKV + 16 * MiB + 16 * MiB, WS_KV = WS_Q + 96 * MiB;
constexpr size_t WS_U = WS_KV + 128 * MiB;
constexpr size_t WS_YF = WS_U, WS_YR = WS_U + 128 * MiB;
constexpr size_t WS_ACT = WS_U + 352 * MiB;
constexpr size_t WS_SSQP = WS_ACT + 176 * MiB;
constexpr size_t WS_S5P = WS_SSQP + 24 * MiB;
constexpr size_t WS_END = WS_S5P + 4 * MiB;

constexpr int LDS_BYTES = 147456;

__device__ __forceinline__ unsigned cvt_pk_bf16(float lo, float hi) { unsigned r; asm volatile("v_cvt_pk_bf16_f32 %0, %1, %2" : "=v"(r) : "v"(lo), "v"(hi)); return r; }
__device__ __forceinline__ float bf2f(unsigned short u) { return __uint_as_float((unsigned)u << 16); }
__device__ __forceinline__ float bflo(unsigned w) { return __uint_as_float(w << 16); }
__device__ __forceinline__ float bfhi(unsigned w) { return __uint_as_float(w & 0xffff0000u); }
__device__ __forceinline__ float wave_sum(float v) {
#pragma unroll
    for (int o = 1; o < 64; o <<= 1) v += __shfl_xor(v, o);
    return v;
}
__device__ __forceinline__ void split_bf16x8(const f32x4 a, const f32x4 b, bf16x8& hi, bf16x8& lo) {
    u32x4 h, l;
    h.x = cvt_pk_bf16(a[0], a[1]); h.y = cvt_pk_bf16(a[2], a[3]); h.z = cvt_pk_bf16(b[0], b[1]); h.w = cvt_pk_bf16(b[2], b[3]);
    l.x = cvt_pk_bf16(a[0] - bflo(h.x), a[1] - bfhi(h.x)); l.y = cvt_pk_bf16(a[2] - bflo(h.y), a[3] - bfhi(h.y));
    l.z = cvt_pk_bf16(b[0] - bflo(h.z), b[1] - bfhi(h.z)); l.w = cvt_pk_bf16(b[2] - bflo(h.w), b[3] - bfhi(h.w));
    hi = __builtin_bit_cast(bf16x8, h); lo = __builtin_bit_cast(bf16x8, l);
}
__device__ __forceinline__ size_t ssq_at(int row, int pn) { return ((size_t)((row >> 8) * 8 + pn) * 256 + (row & 255)) * 4; }
template <int NP> __device__ __forceinline__ float row_rs(const float* ssqp, int row, int fq, float inv_dim) {
    float s;
    if constexpr (NP == 32) { const f32x4 a = *(const f32x4*)(ssqp + ssq_at(row, 2 * fq)), b = *(const f32x4*)(ssqp + ssq_at(row, 2 * fq + 1)); s = ((a[0] + a[1]) + (a[2] + a[3])) + ((b[0] + b[1]) + (b[2] + b[3])); }
    else { const f32x4 a = *(const f32x4*)(ssqp + ssq_at(row, fq & 1)); s = (fq < 2) ? ((a[0] + a[1]) + (a[2] + a[3])) : 0.f; }
    s += __shfl_xor(s, 16); s += __shfl_xor(s, 32);
    return __builtin_amdgcn_rsqf(s * inv_dim + EPS);
}
__device__ __forceinline__ void sincos_d(double x, double& s, double& c) {
    const double kd = rint(x * 0.63661977236758134308);
    double r = fma(-kd, 1.57079632679489655800e+00, x); r = fma(-kd, 6.12323399573676603587e-17, r);
    const int k = (int)kd; const double r2 = r * r;
    const double sp = r * (1.0 + r2 * (-1.0 / 6.0 + r2 * (1.0 / 120.0 + r2 * (-1.0 / 5040.0 + r2 * (1.0 / 362880.0 + r2 * (-1.0 / 39916800.0 + r2 * (1.0 / 6227020800.0 + r2 * (-1.0 / 1307674368000.0))))))));
    const double cp = 1.0 + r2 * (-0.5 + r2 * (1.0 / 24.0 + r2 * (-1.0 / 720.0 + r2 * (1.0 / 40320.0 + r2 * (-1.0 / 3628800.0 + r2 * (1.0 / 479001600.0 + r2 * (-1.0 / 87178291200.0 + r2 * (1.0 / 20922789888000.0))))))));
    const int q = k & 3;
    s = (q == 0) ? sp : (q == 1) ? cp : (q == 2) ? -sp : -cp;
    c = (q == 0) ? cp : (q == 1) ? -sp : (q == 2) ? -cp : sp;
}
__device__ __forceinline__ double exp_d(double x) {
    const double kd = rint(x * 1.44269504088896338700);
    double r = fma(-kd, 6.93147180369123816490e-01, x); r = fma(-kd, 1.90821492927058770002e-10, r);
    double p = 1.0 / 6227020800.0;
    p = p * r + 1.0 / 479001600.0; p = p * r + 1.0 / 39916800.0; p = p * r + 1.0 / 3628800.0; p = p * r + 1.0 / 362880.0; p = p * r + 1.0 / 40320.0;
    p = p * r + 1.0 / 5040.0; p = p * r + 1.0 / 720.0; p = p * r + 1.0 / 120.0; p = p * r + 1.0 / 24.0; p = p * r + 1.0 / 6.0; p = p * r + 0.5; p = p * r + 1.0; p = p * r + 1.0;
    const long long bits = ((long long)((int)kd + 1023)) << 52;
    return p * __longlong_as_double(bits);
}

namespace pg8 {
constexpr int BM = 256, BK = 64, HALF = 128, HTB = HALF * BK * 2, STAGE_BYTES = 8 * HTB, NXCD = 8, WGM = 8;
__host__ __device__ __forceinline__ int lds_byte(int r, int c) { const int st = (r >> 4) * 2 + (c >> 5), rr = r & 15, cc = c & 31, ob = rr * 64 + cc * 2; return st * 1024 + (ob ^ (((ob >> 9) & 1) << 5)); }
__host__ __device__ __forceinline__ void stage_rc(int b, int& R, int& C) { const int st = b / 1024, sb = b % 1024, swz = sb ^ (((sb >> 9) & 1) << 5); R = (st >> 1) * 16 + swz / 64; C = (st & 1) * 32 + (swz % 64) / 2; }
__host__ __device__ __forceinline__ int perm32(int rho) { const int n = rho >> 4, i = rho & 15; return 8 * (i >> 2) + 4 * n + (i & 3); }
struct Unit { int pm, pn; };
struct Gemm { const bf16_t* A; const bf16_t* Bt; int M, N, K, lda, ldb; };
struct StaticOrder {
    int nM, nN, nwg, G, c;
    __device__ void init(int M, int N, int G_, int c_) { nM = M / BM; nN = N / BM; nwg = nM * nN; G = G_; c = c_; }
    __device__ bool next(int i, Unit& u) const {
        const long L = (long)i * G + c; if (L >= nwg) return false;
        int wgid = (int)L; { const int q = nwg / NXCD, r = nwg % NXCD, xcd = wgid % NXCD, off = wgid / NXCD; wgid = (xcd < r ? xcd * (q + 1) : r * (q + 1) + (xcd - r) * q) + off; }
        const int nig = WGM * nN, gid = wgid / nig, fm = gid * WGM, gsz = (nM - fm) < WGM ? (nM - fm) : WGM;
        u.pm = fm + ((wgid % nig) % gsz); u.pn = (wgid % nig) / gsz; return true;
    }
};

struct EpiScaleBf16 {
    static constexpr bool PERM = true;
    bf16_t* O; int ldc; const float* ssq; float inv_dim; bool np8;
    __device__ __forceinline__ void operator()(const f32x4 (&acc)[2][2][4][2], const Unit& u, int wr, int wc, int fr, int fq) const {
        const int row0 = u.pm * BM + wr * 64 + fr, col0 = u.pn * BM + wc * 32 + 8 * fq;
#pragma unroll
        for (int ai = 0; ai < 2; ++ai)
#pragma unroll
            for (int m = 0; m < 4; ++m) {
                const int row = row0 + ai * HALF + m * 16;
                const float rs = np8 ? row_rs<8>(ssq, row, fq, inv_dim) : row_rs<32>(ssq, row, fq, inv_dim);
                bf16_t* rowp = O + (size_t)row * ldc + col0;
#pragma unroll
                for (int bj = 0; bj < 2; ++bj) {
                    const f32x4 v0 = acc[ai][bj][m][0] * rs, v1 = acc[ai][bj][m][1] * rs;
                    u32x4 w; w.x = cvt_pk_bf16(v0[0], v0[1]); w.y = cvt_pk_bf16(v0[2], v0[3]); w.z = cvt_pk_bf16(v1[0], v1[1]); w.w = cvt_pk_bf16(v1[2], v1[3]);
                    *(u32x4*)(rowp + bj * HALF) = w;
                }
            }
    }
};
struct EpiResidual {
    static constexpr bool PERM = false;
    const float* Xin; float* Xout; bf16_t* XB; float* ssq_out; const bf16_t* Z; const float* bias;
    __device__ __forceinline__ void operator()(const f32x4 (&acc)[2][2][4][2], const Unit& u, int wr, int wc, int fr, int fq) const {
        const int row0 = u.pm * BM + wr * 64 + fr, col0 = u.pn * BM + wc * 32 + 4 * fq;
#pragma unroll
        for (int ai = 0; ai < 2; ++ai)
#pragma unroll
            for (int m = 0; m < 4; ++m) {
                const int row = row0 + ai * HALF + m * 16; const size_t off = (size_t)row * D + col0; float ss = 0.f;
#pragma unroll
                for (int bj = 0; bj < 2; ++bj)
#pragma unroll
                    for (int n = 0; n < 2; ++n) {
                        const size_t o = off + bj * HALF + n * 16; f32x4 a = acc[ai][bj][m][n];
                        if (Z) {
                            const u32x2 zz = *(const u32x2*)(Z + o); const f32x4 bv = *(const f32x4*)(bias + col0 + bj * HALF + n * 16);
                            const float z0 = bflo(zz.x), z1 = bfhi(zz.x), z2 = bflo(zz.y), z3 = bfhi(zz.y);
                            a[0] = z0 * __builtin_amdgcn_rcpf(1.f + __expf(-(a[0] + bv[0]))); a[1] = z1 * __builtin_amdgcn_rcpf(1.f + __expf(-(a[1] + bv[1])));
                            a[2] = z2 * __builtin_amdgcn_rcpf(1.f + __expf(-(a[2] + bv[2]))); a[3] = z3 * __builtin_amdgcn_rcpf(1.f + __expf(-(a[3] + bv[3])));
                        }
                        f32x4 x = *(const f32x4*)(Xin + o); x = x + a;
                        *(f32x4*)(Xout + o) = x;
                        u32x2 w; w.x = cvt_pk_bf16(x[0], x[1]); w.y = cvt_pk_bf16(x[2], x[3]); *(u32x2*)(XB + o) = w;
                        ss += (x[0] * x[0] + x[1] * x[1]) + (x[2] * x[2] + x[3] * x[3]);
                    }
                ss += __shfl_xor(ss, 16); ss += __shfl_xor(ss, 32);
                if (fq == 0) ssq_out[ssq_at(row, u.pn) + wc] = ss;
                asm volatile("" ::: "memory");
            }
    }
};
struct EpiDqkv {
    static constexpr bool PERM = false;
    bf16_t* CQ; bf16_t* CKV; bf16_t* KR; const float* ssq_in; float* ssq_q; float* ssq_kv; const float* cosT; const float* sinT;
    __device__ __forceinline__ void operator()(const f32x4 (&acc)[2][2][4][2], const Unit& u, int wr, int wc, int fr, int fq) const {
        const int row0 = u.pm * BM + wr * 64 + fr, lcol0 = wc * 32 + 4 * fq;
#pragma unroll
        for (int ai = 0; ai < 2; ++ai)
#pragma unroll
            for (int m = 0; m < 4; ++m) {
                const int row = row0 + ai * HALF + m * 16;
                const float rs = row_rs<32>(ssq_in, row, fq, 1.f / D);
                if (u.pn < 4) {
                    bf16_t* dst = (u.pn < 2 ? CQ : CKV) + (size_t)row * 512 + (u.pn & 1) * 256 + lcol0; float ss = 0.f;
#pragma unroll
                    for (int bj = 0; bj < 2; ++bj)
#pragma unroll
                        for (int n = 0; n < 2; ++n) {
                            const f32x4 v = acc[ai][bj][m][n] * rs;
                            u32x2 w; w.x = cvt_pk_bf16(v[0], v[1]); w.y = cvt_pk_bf16(v[2], v[3]); *(u32x2*)(dst + bj * HALF + n * 16) = w;
                            ss += (v[0] * v[0] + v[1] * v[1]) + (v[2] * v[2] + v[3] * v[3]);
                        }
                    ss += __shfl_xor(ss, 16); ss += __shfl_xor(ss, 32);
                    if (fq == 0) (u.pn < 2 ? ssq_q : ssq_kv)[ssq_at(row, u.pn & 1) + wc] = ss;
                } else if (wc < 2) {
                    const int i0 = 16 * wc + 4 * fq, pos = row & (SEQ - 1);
                    const f32x4 cs = *(const f32x4*)(cosT + pos * 32 + i0), sn = *(const f32x4*)(sinT + pos * 32 + i0);
                    const f32x4 x1 = acc[ai][0][m][0] * rs, x2 = acc[ai][0][m][1] * rs;
                    const f32x4 y1 = x1 * cs - x2 * sn, y2 = x2 * cs + x1 * sn;
                    u32x2 w; w.x = cvt_pk_bf16(y1[0], y1[1]); w.y = cvt_pk_bf16(y1[2], y1[3]); *(u32x2*)(KR + (size_t)row * 64 + i0) = w;
                    w.x = cvt_pk_bf16(y2[0], y2[1]); w.y = cvt_pk_bf16(y2[2], y2[3]); *(u32x2*)(KR + (size_t)row * 64 + 32 + i0) = w;
                }
            }
    }
};

template <class Epi, bool ALIGN_EPI>
__device__ __forceinline__ void gemm_phase(LAS unsigned char* lds, const Gemm g, const StaticOrder& S, const Epi& E) {
    int tid = threadIdx.x; asm volatile("" : "+v"(tid));
    const int wid = __builtin_amdgcn_readfirstlane(tid >> 6), lane = tid & 63, wr = wid >> 2, wc = wid & 3, fr = lane & 15, fq = lane >> 4;
    const int K = g.K, nt = K / BK;
    unsigned voffA[2], voffB[2];
#pragma unroll
    for (int i = 0; i < 2; ++i) { int R, C; stage_rc(tid * 16 + i * 8192, R, C); const int Rb = Epi::PERM ? ((R & ~31) + perm32(R & 31)) : R;
        voffA[i] = (unsigned)(R * g.lda + C) * 2u; voffB[i] = (unsigned)(Rb * g.ldb + C) * 2u; }
    const size_t kstep = (size_t)(BK * 2);
    const size_t hstepA = (size_t)HALF * g.lda * 2, hstepB = (size_t)HALF * g.ldb * 2;
    const size_t tstepA = 2 * hstepA, tstepB = 2 * hstepB;
    const unsigned ldsw = (unsigned)wid * 1024u;
    const int aoff = lds_byte(wr * 64 + fr, fq * 8), boff = lds_byte(wc * 32 + fr, fq * 8);
#define PG8_SA(b, h) (((b) * 2 + (h)) * HTB)
#define PG8_SB(b, h) ((4 + (b) * 2 + (h)) * HTB)
#define PG8_STAGE(bufoff, gbase, voff) do { _Pragma("unroll") for (int _i = 0; _i < 2; ++_i) \
        __builtin_amdgcn_global_load_lds((const unsigned*)((const char*)(gbase) + (voff)[_i]), (LAS unsigned*)(lds + (bufoff) + ldsw + _i * 8192), 16, 0, 0); } while (0)
#define PG8_LDA(dst, b, h) do { _Pragma("unroll") for (int m = 0; m < 4; ++m) _Pragma("unroll") for (int k = 0; k < 2; ++k) dst[m][k] = *(const LAS bf16x8*)(lds + PG8_SA(b, h) + aoff + m * 2048 + k * 1024); } while (0)
#define PG8_LDB(dst, b, h) do { _Pragma("unroll") for (int n = 0; n < 2; ++n) _Pragma("unroll") for (int k = 0; k < 2; ++k) dst[n][k] = *(const LAS bf16x8*)(lds + PG8_SB(b, h) + boff + n * 2048 + k * 1024); } while (0)
#define PG8_MMA(ai, bj, At, Bt) do { __builtin_amdgcn_s_setprio(1); _Pragma("unroll") for (int m = 0; m < 4; ++m) _Pragma("unroll") for (int n = 0; n < 2; ++n) _Pragma("unroll") for (int k = 0; k < 2; ++k) \
        acc[ai][bj][m][n] = __builtin_amdgcn_mfma_f32_16x16x32_bf16(Bt[n][k], At[m][k], acc[ai][bj][m][n], 0, 0, 0); __builtin_amdgcn_s_setprio(0); } while (0)
#define PG8_WAIT_V(n) asm volatile("s_waitcnt vmcnt(" #n ")" ::: "memory")
#define PG8_WAIT_L(n) asm volatile("s_waitcnt lgkmcnt(" #n ")" ::: "memory")
#define PG8_BAR __builtin_amdgcn_s_barrier()
#define PG8_SCHED __builtin_amdgcn_sched_barrier(0)
    Unit cur, nxt; int ui = 0;
    if (!S.next(0, cur)) return;
    f32x4 acc[2][2][4][2];
#pragma unroll
    for (int a = 0; a < 2; ++a)
#pragma unroll
        for (int b = 0; b < 2; ++b)
#pragma unroll
            for (int m = 0; m < 4; ++m)
#pragma unroll
                for (int n = 0; n < 2; ++n) acc[a][b][m][n] = (f32x4){0.f, 0.f, 0.f, 0.f};
    bf16x8 At[4][2], B0[2][2], B1[2][2];
    const char* cA = (const char*)g.A + (size_t)cur.pm * tstepA; const char* cB = (const char*)g.Bt + (size_t)cur.pn * tstepB;
    PG8_STAGE(PG8_SB(0, 0), cB, voffB); PG8_STAGE(PG8_SB(0, 1), cB + hstepB, voffB); PG8_STAGE(PG8_SA(0, 0), cA, voffA); PG8_STAGE(PG8_SA(0, 1), cA + hstepA, voffA);
    if (wr == 1) PG8_BAR;
    PG8_WAIT_V(2); PG8_BAR;
    PG8_STAGE(PG8_SB(1, 0), cB + kstep, voffB); PG8_STAGE(PG8_SA(1, 0), cA + kstep, voffA); PG8_STAGE(PG8_SB(1, 1), cB + hstepB + kstep, voffB);
    PG8_WAIT_V(6); PG8_BAR;
    for (;;) {
        const bool has_next = S.next(ui + 1, nxt);
        const char* nA = has_next ? (const char*)g.A + (size_t)nxt.pm * tstepA : cA; const char* nB = has_next ? (const char*)g.Bt + (size_t)nxt.pn * tstepB : cB;
        for (int t = 0; t < nt; t += 2) {
            const bool last = (t == nt - 2);
            const char* a1 = cA + (size_t)(t + 1) * kstep;
            const char* a2 = last ? nA : cA + (size_t)(t + 2) * kstep; const char* b2 = last ? nB : cB + (size_t)(t + 2) * kstep;
            const char* a3 = a2 + kstep; const char* b3 = b2 + kstep;
            PG8_LDB(B0, 0, 0); PG8_LDB(B1, 0, 1); PG8_SCHED; PG8_LDA(At, 0, 0); PG8_STAGE(PG8_SA(1, 1), a1 + hstepA, voffA);
            PG8_WAIT_V(8); PG8_WAIT_L(0); PG8_BAR; PG8_MMA(0, 0, At, B0); PG8_MMA(0, 1, At, B1); PG8_BAR; PG8_SCHED;
            PG8_LDA(At, 0, 1); PG8_STAGE(PG8_SB(0, 0), b2, voffB); PG8_STAGE(PG8_SB(0, 1), b2 + hstepB, voffB); PG8_STAGE(PG8_SA(0, 0), a2, voffA);
            PG8_WAIT_V(8); PG8_WAIT_L(0); PG8_BAR; PG8_MMA(1, 0, At, B0); PG8_MMA(1, 1, At, B1); PG8_BAR; PG8_SCHED;
            PG8_LDB(B0, 1, 0); PG8_LDB(B1, 1, 1); PG8_SCHED; PG8_LDA(At, 1, 0); PG8_STAGE(PG8_SA(0, 1), a2 + hstepA, voffA);
            PG8_WAIT_V(8); PG8_WAIT_L(0); PG8_BAR; PG8_MMA(0, 0, At, B0); PG8_MMA(0, 1, At, B1); PG8_BAR; PG8_SCHED;
            PG8_LDA(At, 1, 1); PG8_STAGE(PG8_SB(1, 0), b3, voffB); PG8_STAGE(PG8_SB(1, 1), b3 + hstepB, voffB); PG8_STAGE(PG8_SA(1, 0), a3, voffA);
            PG8_WAIT_V(8); PG8_WAIT_L(0); PG8_BAR; PG8_MMA(1, 0, At, B0); PG8_MMA(1, 1, At, B1); PG8_BAR; PG8_SCHED;
        }
        if constexpr (ALIGN_EPI) { if (wr == 0) PG8_BAR; }
        E(acc, cur, wr, wc, fr, fq);
        if (!has_next) break;
#pragma unroll
        for (int a = 0; a < 2; ++a)
#pragma unroll
            for (int b = 0; b < 2; ++b)
#pragma unroll
                for (int m = 0; m < 4; ++m)
#pragma unroll
                    for (int n = 0; n < 2; ++n) acc[a][b][m][n] = (f32x4){0.f, 0.f, 0.f, 0.f};
        cur = nxt; cA = nA; cB = nB; ++ui;
        if constexpr (ALIGN_EPI) { if (wr == 1) PG8_BAR; }
    }
    PG8_WAIT_V(0);
    if constexpr (!ALIGN_EPI) { if (wr == 0) PG8_BAR; }
    PG8_BAR;
#undef PG8_SA
#undef PG8_SB
#undef PG8_STAGE
#undef PG8_LDA
#undef PG8_LDB
#undef PG8_MMA
#undef PG8_WAIT_V
#undef PG8_WAIT_L
#undef PG8_BAR
#undef PG8_SCHED
}
}

struct AttnPtrs { const bf16_t* Q; int ldq, qoff; const bf16_t* K; int ldk, koff; const bf16_t* K2; int ldk2; const bf16_t* V; int ldv, voff; bf16_t* O; int ldo, ooff; };
template <int DQK, int DV, bool WIN>
__device__ __forceinline__ void attn_unit(LAS unsigned char* lds, const int b, const int qb, const AttnPtrs P, const float* cosT, const float* sinT, const float slope_l2, const float sink_l2) {
    constexpr int KP = DQK * 2 + 16, VP = DV * 2 + 64, KBUF = 64 * KP, VBUF = 64 * VP, BUF = KBUF + VBUF;
    constexpr int NKC = DQK / 8, NVC = DV / 8, KCH = 64 * NKC / 512, VCH = 64 * NVC / 512, ND0 = DQK / 16, NDB = DV / 32;
    constexpr int DK1 = WIN ? DQK : 128;
    static_assert(2 * BUF <= 131072, "attention LDS");
    int tid = threadIdx.x; asm volatile("" : "+v"(tid));
    const int lane = tid & 63, wid = __builtin_amdgcn_readfirstlane(tid >> 6), r32 = lane & 31, hi = lane >> 5;
    const long rowbase = (long)b * SEQ; const int q0 = qb * 256, qw = q0 + wid * 32, qabs = qw + r32;
    bf16x8 qr[ND0];
    { const bf16_t* qrow = P.Q + (size_t)(rowbase + qabs) * P.ldq + P.qoff;
#pragma unroll
      for (int d0 = 0; d0 < ND0; ++d0) qr[d0] = *(const bf16x8*)(qrow + 16 * d0 + 8 * hi);
      if constexpr (!WIN) {
#pragma unroll
          for (int dd = 0; dd < 2; ++dd) {
              const int i0 = 16 * dd + 8 * hi;
              const f32x4 c0 = *(const f32x4*)(cosT + qabs * 32 + i0), c1 = *(const f32x4*)(cosT + qabs * 32 + i0 + 4);
              const f32x4 s0 = *(const f32x4*)(sinT + qabs * 32 + i0), s1 = *(const f32x4*)(sinT + qabs * 32 + i0 + 4);
              bf16x8 a = qr[8 + dd], c = qr[10 + dd];
#pragma unroll
              for (int j = 0; j < 8; j += 2) {
                  const float cs0 = j < 4 ? c0[j] : c1[j - 4], cs1 = j < 4 ? c0[j + 1] : c1[j - 3], sn0 = j < 4 ? s0[j] : s1[j - 4], sn1 = j < 4 ? s0[j + 1] : s1[j - 3];
                  const float x10 = bf2f((unsigned short)a[j]), x11 = bf2f((unsigned short)a[j + 1]), x20 = bf2f((unsigned short)c[j]), x21 = bf2f((unsigned short)c[j + 1]);
                  const unsigned w1 = cvt_pk_bf16(x10 * cs0 - x20 * sn0, x11 * cs1 - x21 * sn1), w2 = cvt_pk_bf16(x20 * cs0 + x10 * sn0, x21 * cs1 + x11 * sn1);
                  a[j] = (short)(w1 & 0xffff); a[j + 1] = (short)(w1 >> 16); c[j] = (short)(w2 & 0xffff); c[j + 1] = (short)(w2 >> 16);
              }
              qr[8 + dd] = a; qr[10 + dd] = c;
          }
      }
    }
    const int t_begin = WIN ? ((q0 == 0) ? 2 : 0) : 0, t_end = WIN ? ((q0 + 256 == SEQ) ? 6 : 8) : (SEQ / 64);
    const int kt_lo = WIN ? (q0 - 128) : 0;
    float m_run = WIN ? sink_l2 : -INFINITY, l_run = (WIN && hi == 0) ? 1.f : 0.f;
    f32x16 oT[NDB];
#pragma unroll
    for (int i = 0; i < NDB; ++i) oT[i] = (f32x16){0.f, 0.f, 0.f, 0.f, 0.f, 0.f, 0.f, 0.f, 0.f, 0.f, 0.f, 0.f, 0.f, 0.f, 0.f, 0.f};
    u32x4 stK[KCH], stV[VCH];
    auto load_tile = [&](int t) __attribute__((always_inline)) {
        const int kt = kt_lo + 64 * t;
#pragma unroll
        for (int i = 0; i < KCH; ++i) { const int ck = tid + 512 * i, key = ck / NKC, c = ck % NKC; int ka = kt + key; if (WIN) ka = ka < 0 ? 0 : (ka > SEQ - 1 ? SEQ - 1 : ka);
            const bf16_t* src = (8 * c < DK1) ? P.K + (size_t)(rowbase + ka) * P.ldk + P.koff + 8 * c : P.K2 + (size_t)(rowbase + ka) * P.ldk2 + (8 * c - DK1);
            stK[i] = *(const u32x4*)src; }
#pragma unroll
        for (int i = 0; i < VCH; ++i) { const int cv = tid + 512 * i, key = cv / NVC, c = cv % NVC; int ka = kt + key; if (WIN) ka = ka < 0 ? 0 : (ka > SEQ - 1 ? SEQ - 1 : ka);
            stV[i] = *(const u32x4*)(P.V + (size_t)(rowbase + ka) * P.ldv + P.voff + 8 * c); }
    };
    auto store_tile = [&](int buf) __attribute__((always_inline)) {
        LAS unsigned char* kb = lds + buf * BUF; LAS unsigned char* vb = kb + KBUF;
#pragma unroll
        for (int i = 0; i < KCH; ++i) { const int ck = tid + 512 * i, key = ck / NKC, c = ck % NKC; *(LAS u32x4*)(kb + key * KP + c * 16) = stK[i]; }
#pragma unroll
        for (int i = 0; i < VCH; ++i) { const int cv = tid + 512 * i, key = cv / NVC, c = cv % NVC; *(LAS u32x4*)(vb + key * VP + c * 16) = stV[i]; }
    };
    load_tile(t_begin); store_tile(0);
    __syncthreads();
    const int vrd = (4 * hi + ((lane & 15) >> 2)) * VP + (16 * ((lane >> 4) & 1) + 4 * (lane & 3)) * 2;
    int buf = 0;
    for (int t = t_begin; t < t_end; ++t) {
        const bool more = (t + 1 < t_end);
        if (more) load_tile(t + 1);
        const int kt = kt_lo + 64 * t;
        bool active = true;
        if constexpr (WIN) active = (kt + 63 >= qw - 128) && (kt <= qw + 159);
        if (active) {
            LAS unsigned char* kb = lds + buf * BUF; LAS unsigned char* vb = kb + KBUF;
            f32x16 p0 = (f32x16){0.f, 0.f, 0.f, 0.f, 0.f, 0.f, 0.f, 0.f, 0.f, 0.f, 0.f, 0.f, 0.f, 0.f, 0.f, 0.f}, p1 = p0;
#pragma unroll
            for (int d0 = 0; d0 < ND0; ++d0) {
                const bf16x8 k0 = *(const LAS bf16x8*)(kb + r32 * KP + d0 * 32 + hi * 16);
                const bf16x8 k1 = *(const LAS bf16x8*)(kb + (32 + r32) * KP + d0 * 32 + hi * 16);
                p0 = __builtin_amdgcn_mfma_f32_32x32x16_bf16(k0, qr[d0], p0, 0, 0, 0);
                p1 = __builtin_amdgcn_mfma_f32_32x32x16_bf16(k1, qr[d0], p1, 0, 0, 0);
            }
            if constexpr (WIN) {
                const float relb = (float)(kt + 4 * hi - qabs);
#pragma unroll
                for (int r = 0; r < 16; ++r) {
                    const float x0 = relb + (float)((r & 3) + 8 * (r >> 2)), x1 = x0 + 32.f;
                    const float a0 = __builtin_fabsf(x0), a1 = __builtin_fabsf(x1);
                    p0[r] = (a0 <= 128.f) ? fmaf(-slope_l2, a0, p0[r]) : -INFINITY; p1[r] = (a1 <= 128.f) ? fmaf(-slope_l2, a1, p1[r]) : -INFINITY;
                }
            }
            float mx = fmaxf(p0[0], p1[0]);
#pragma unroll
            for (int r = 1; r < 16; ++r) mx = fmaxf(mx, fmaxf(p0[r], p1[r]));
            mx = fmaxf(mx, __shfl_xor(mx, 32));
            const float m_new = fmaxf(m_run, mx);
            const float alpha = __builtin_amdgcn_exp2f(m_run - m_new);
            float ps = 0.f;
#pragma unroll
            for (int r = 0; r < 16; ++r) { p0[r] = __builtin_amdgcn_exp2f(p0[r] - m_new); p1[r] = __builtin_amdgcn_exp2f(p1[r] - m_new); ps += p0[r] + p1[r]; }
            l_run = l_run * alpha + ps; m_run = m_new;
            if (__any(alpha != 1.f)) {
#pragma unroll
                for (int i = 0; i < NDB; ++i)
#pragma unroll
                    for (int r = 0; r < 16; ++r) oT[i][r] *= alpha;
            }
            bf16x8 pf[2][2];
#pragma unroll
            for (int s = 0; s < 2; ++s) {
                u32x4 w0, w1;
                w0.x = cvt_pk_bf16(p0[8 * s + 0], p0[8 * s + 1]); w0.y = cvt_pk_bf16(p0[8 * s + 2], p0[8 * s + 3]); w0.z = cvt_pk_bf16(p0[8 * s + 4], p0[8 * s + 5]); w0.w = cvt_pk_bf16(p0[8 * s + 6], p0[8 * s + 7]);
                w1.x = cvt_pk_bf16(p1[8 * s + 0], p1[8 * s + 1]); w1.y = cvt_pk_bf16(p1[8 * s + 2], p1[8 * s + 3]); w1.z = cvt_pk_bf16(p1[8 * s + 4], p1[8 * s + 5]); w1.w = cvt_pk_bf16(p1[8 * s + 6], p1[8 * s + 7]);
                pf[0][s] = __builtin_bit_cast(bf16x8, w0); pf[1][s] = __builtin_bit_cast(bf16x8, w1);
            }
#pragma unroll
            for (int db = 0; db < NDB; ++db)
#pragma unroll
                for (int kk = 0; kk < 2; ++kk)
#pragma unroll
                    for (int s = 0; s < 2; ++s) {
                        LAS unsigned char* vp = vb + vrd + (kk * 32 + 16 * s) * VP + db * 64;
                        const v4i16_t lo = __builtin_amdgcn_ds_read_tr16_b64_v4i16((LAS v4i16_t*)vp);
                        const v4i16_t hh = __builtin_amdgcn_ds_read_tr16_b64_v4i16((LAS v4i16_t*)(vp + 8 * VP));
                        const bf16x8 vf = (bf16x8){lo[0], lo[1], lo[2], lo[3], hh[0], hh[1], hh[2], hh[3]};
                        oT[db] = __builtin_amdgcn_mfma_f32_32x32x16_bf16(vf, pf[kk][s], oT[db], 0, 0, 0);
                    }
        }
        if (more) store_tile(buf ^ 1);
        __syncthreads();
        buf ^= 1;
    }
    const float lt = l_run + __shfl_xor(l_run, 32); const float inv = 1.f / lt;
    bf16_t* orow = P.O + (size_t)(rowbase + qabs) * P.ldo + P.ooff;
#pragma unroll
    for (int db = 0; db < NDB; ++db)
#pragma unroll
        for (int g4 = 0; g4 < 4; ++g4) {
            u32x2 w; w.x = cvt_pk_bf16(oT[db][4 * g4] * inv, oT[db][4 * g4 + 1] * inv); w.y = cvt_pk_bf16(oT[db][4 * g4 + 2] * inv, oT[db][4 * g4 + 3] * inv);
            *(u32x2*)(orow + 32 * db + 8 * g4 + 4 * hi) = w;
        }
}

struct Args { const float* in[27]; float* out; unsigned char* ws; };
enum { I_X = 0, I_MIXN, I_FFNN, I_FINN, I_AQKV, I_AWO, I_ASINK, I_SARE, I_SAIM, I_SLS, I_SBRE, I_SBIM, I_SCRE, I_SCIM, I_SD, I_SWGLU, I_SBGLU, I_MDQ, I_MQN, I_MKVN, I_MUQ, I_MUKV, I_MWO, I_FUP, I_FCW, I_FCB, I_FDOWN };

__device__ __forceinline__ void tr_item(const float* __restrict__ W, int K, int N, bf16_t* WT, const float* gain, int scale_n, float scale, bool ropeperm, LAS float* scr, int item, int lane) {
    const int nblk = N / 32, kb = item / nblk, nb = item % nblk, k0 = 64 * kb, n0 = 32 * nb;
    {
        f32x4 v[8]; const int n4 = (lane & 7) * 4;
#pragma unroll
        for (int i = 0; i < 8; ++i) v[i] = *(const f32x4*)(W + (size_t)(k0 + 8 * i + (lane >> 3)) * N + n0 + n4);
#pragma unroll
        for (int i = 0; i < 8; ++i) { const int kk = 8 * i + (lane >> 3); const float gk = gain ? gain[k0 + kk] : 1.f;
            scr[kk * 33 + n4] = v[i][0] * gk; scr[kk * 33 + n4 + 1] = v[i][1] * gk; scr[kk * 33 + n4 + 2] = v[i][2] * gk; scr[kk * 33 + n4 + 3] = v[i][3] * gk; }
    }
    asm volatile("s_waitcnt lgkmcnt(0)" ::: "memory");
    const int c = lane & 7;
#pragma unroll
    for (int j = 0; j < 4; ++j) { const int nl = (lane >> 3) + 8 * j, n = n0 + nl; const LAS float* s = scr + (8 * c) * 33 + nl;
        const float sc = (n < scale_n) ? scale : 1.f;
        u32x4 o; o.x = cvt_pk_bf16(s[0 * 33] * sc, s[1 * 33] * sc); o.y = cvt_pk_bf16(s[2 * 33] * sc, s[3 * 33] * sc); o.z = cvt_pk_bf16(s[4 * 33] * sc, s[5 * 33] * sc); o.w = cvt_pk_bf16(s[6 * 33] * sc, s[7 * 33] * sc);
        int row = n;
        if (ropeperm && n >= 1024) { const int dim = n - 1024; row = 1024 + 32 * ((dim & 31) >> 4) + 16 * (dim >> 5) + (dim & 15); }
        *(u32x4*)(WT + (size_t)row * K + k0 + 8 * c) = o; }
    asm volatile("s_waitcnt lgkmcnt(0)" ::: "memory");
}

#define FRESH_IDS() int tid = threadIdx.x; asm volatile("" : "+v"(tid)); const int lane = tid & 63, wave = __builtin_amdgcn_readfirstlane(tid >> 6); \
    const int G = gridDim.x, bx = blockIdx.x; const int gw = bx * 8 + wave, NGW = G * 8; const size_t gt = (size_t)bx * 512 + tid, NGT = (size_t)G * 512; \
    unsigned char* ws = args.ws; asm volatile("" : "+s"(ws)); (void)lane; (void)wave; (void)gw; (void)NGW; (void)gt; (void)NGT; (void)G; (void)bx
#define SSQ(i) ((float*)(ws + WS_SSQP) + (size_t)(i) * T * 32)

__device__ __forceinline__ void phase_prologue(const Args& args, LAS unsigned char* lds) {
    FRESH_IDS();
    LAS float* scr = (LAS float*)(lds + wave * 16384);
    const float SC_A = 0.125f * LOG2E, SC_M = 0.07216878364870322f * LOG2E;
#define CONV(Wp, K_, N_, dst, gain_, sn, sc, rp) do { const int nit = ((K_) / 64) * ((N_) / 32); for (int it = gw; it < nit; it += NGW) tr_item((Wp), (K_), (N_), (bf16_t*)(ws + (dst)), (gain_), (sn), (sc), (rp), scr, it, lane); } while (0)
    CONV(args.in[I_AQKV], D, NQKV, W_QKV0, args.in[I_MIXN] + 0 * D, 2048, SC_A, false);
    CONV(args.in[I_AQKV] + (size_t)D * NQKV, D, NQKV, W_QKV1, args.in[I_MIXN] + 3 * D, 2048, SC_A, false);
    CONV(args.in[I_AWO], D, D, W_WO0, nullptr, 0, 1.f, false);
    CONV(args.in[I_AWO] + (size_t)D * D, D, D, W_WO1, nullptr, 0, 1.f, false);
    CONV(args.in[I_SWGLU], D, D, W_GLU, nullptr, 0, 1.f, false);
    CONV(args.in[I_MDQ], D, 1088, W_DQ, args.in[I_MIXN] + 2 * D, 0, 1.f, true);
    CONV(args.in[I_MUQ], 512, NUQ, W_UQ, args.in[I_MQN], NUQ, SC_M, false);
    CONV(args.in[I_MUKV], 512, NUKV, W_UKV, args.in[I_MKVN], 0, 1.f, false);
    CONV(args.in[I_MWO], D, D, W_MWO, nullptr, 0, 1.f, false);
#pragma unroll 1
    for (int l = 0; l < 4; ++l) {
        CONV(args.in[I_FUP] + (size_t)l * D * NUP, D, NUP, W_UP + (size_t)l * 44 * MiB, args.in[I_FFNN] + l * D, 0, 1.f, false);
        CONV(args.in[I_FDOWN] + (size_t)l * DFF * D, DFF, D, W_DOWN + (size_t)l * 22 * MiB, nullptr, 0, 1.f, false);
    }
#undef CONV
    { u32x4* z = (u32x4*)(ws + W_DQ + (size_t)1088 * D * 2); const size_t n16 = (size_t)(NDQ - 1088) * D * 2 / 16; for (size_t i = gt; i < n16; i += NGT) z[i] = (u32x4){0u, 0u, 0u, 0u}; }
    const float* xin = args.in[I_X]; bf16_t* XB = (bf16_t*)(ws + WS_XB); float* ssq = SSQ(0);
    for (int row = gw; row < T; row += NGW) {
        const f32x4* xr = (const f32x4*)(xin + (size_t)row * D) + lane; u32x2* o8 = (u32x2*)(XB + (size_t)row * D) + lane; float s = 0.f;
#pragma unroll
        for (int j = 0; j < 8; ++j) { const f32x4 v = xr[64 * j]; s += (v[0] * v[0] + v[1] * v[1]) + (v[2] * v[2] + v[3] * v[3]); u32x2 w; w.x = cvt_pk_bf16(v[0], v[1]); w.y = cvt_pk_bf16(v[2], v[3]); o8[64 * j] = w; }
        s = wave_sum(s); if (lane < 32) ssq[ssq_at(row, lane >> 2) + (lane & 3)] = (lane == 0) ? s : 0.f;
    }
    float* cosT = (float*)(ws + WS_ROPE); float* sinT = cosT + SEQ * 32;
    for (size_t i = gt; i < (size_t)SEQ * 32; i += NGT) {
        const int pos = (int)(i >> 5), fi = (int)(i & 31);
        const double inv = exp_d(-(double)fi * (9.210340371976184 / 32.0)); double s, c; sincos_d((double)pos * inv, s, c);
        cosT[i] = (float)c; sinT[i] = (float)s;
    }
    float* s5p = (float*)(ws + WS_S5P);
    for (size_t pidx = gt; pidx < (size_t)2 * 128 * 64; pidx += NGT) {
        const double are = (double)args.in[I_SARE][pidx], aim = (double)args.in[I_SAIM][pidx];
        const double step = exp_d((double)args.in[I_SLS][pidx >> 6]);
        const double mag = exp_d(step * are); double sn, cs; sincos_d(step * aim, sn, cs);
        const double lr = mag * cs, li = mag * sn, nre = lr - 1.0, nim = li, den = are * are + aim * aim;
        const double cre = (nre * are + nim * aim) / den, cim = (nim * are - nre * aim) / den;
        float* o = s5p + pidx * 64; o[0] = (float)lr; o[1] = (float)li; o[2] = 0.f; o[3] = 0.f;
        const float* bre = args.in[I_SBRE] + pidx * 16; const float* bim = args.in[I_SBIM] + pidx * 16;
        for (int c = 0; c < 16; ++c) { const double br = (double)bre[c], bi = (double)bim[c]; o[4 + c] = (float)(cre * br - cim * bi); o[20 + c] = (float)(cre * bi + cim * br); }
    }
}

__device__ __forceinline__ void phase_gemm_scale(const Args& args, LAS unsigned char* lds, size_t a_off, int lda, size_t w_off, int N, int K, size_t o_off, int ssq_idx, float inv_dim, bool np8) {
    unsigned char* ws = args.ws; asm volatile("" : "+s"(ws));
    pg8::Gemm g{(const bf16_t*)(ws + a_off), (const bf16_t*)(ws + w_off), T, N, K, lda, K}; pg8::StaticOrder S; S.init(T, N, gridDim.x, blockIdx.x);
    pg8::EpiScaleBf16 E{(bf16_t*)(ws + o_off), N, SSQ(ssq_idx), inv_dim, np8};
    pg8::gemm_phase<pg8::EpiScaleBf16, true>(lds, g, S, E);
}
__device__ __forceinline__ void phase_gemm_resid(const Args& args, LAS unsigned char* lds, size_t a_off, size_t w_off, int K, const float* Xin, int ssq_out, bool glu) {
    unsigned char* ws = args.ws; asm volatile("" : "+s"(ws));
    pg8::Gemm g{(const bf16_t*)(ws + a_off), (const bf16_t*)(ws + w_off), T, D, K, K, K}; pg8::StaticOrder S; S.init(T, D, gridDim.x, blockIdx.x);
    pg8::EpiResidual E{Xin, args.out, (bf16_t*)(ws + WS_XB), SSQ(ssq_out), glu ? (const bf16_t*)(ws + WS_OB) : nullptr, args.in[I_SBGLU]};
    pg8::gemm_phase<pg8::EpiResidual, true>(lds, g, S, E);
}
__device__ __forceinline__ void phase_dqkv(const Args& args, LAS unsigned char* lds, int ssq_in) {
    unsigned char* ws = args.ws; asm volatile("" : "+s"(ws));
    pg8::Gemm g{(const bf16_t*)(ws + WS_XB), (const bf16_t*)(ws + W_DQ), T, NDQ, D, D, D}; pg8::StaticOrder S; S.init(T, NDQ, gridDim.x, blockIdx.x);
    float* cosT = (float*)(ws + WS_ROPE);
    pg8::EpiDqkv E{(bf16_t*)(ws + WS_CQ), (bf16_t*)(ws + WS_CKV), (bf16_t*)(ws + WS_KR), SSQ(ssq_in), SSQ(9), SSQ(10), cosT, cosT + SEQ * 32};
    pg8::gemm_phase<pg8::EpiDqkv, true>(lds, g, S, E);
}
__device__ __forceinline__ void phase_conv(const Args& args, int l) {
    FRESH_IDS();
    const bf16_t* U = (const bf16_t*)(ws + WS_U); bf16_t* ACT = (bf16_t*)(ws + WS_ACT);
    const float* cw = args.in[I_FCW] + (size_t)l * 3 * NUP; const float* cb = args.in[I_FCB] + (size_t)l * NUP;
    constexpr int NCC = DFF / 8; const int NSLOT = (int)(NGT / NCC), SL = T / NSLOT, REM = T - NSLOT * SL;
    for (int pass = 0; pass < 2; ++pass) {
        int cc, t0, TT;
        if (pass == 0) { if (gt >= (size_t)NSLOT * NCC) continue; cc = (int)(gt % NCC); t0 = (int)(gt / NCC) * SL; TT = SL; }
        else { if (REM == 0 || gt >= (size_t)NCC) continue; cc = (int)gt; t0 = NSLOT * SL; TT = REM; }
        const int j0 = cc * 8;
        float wg[3][8], wv[3][8], bg[8], bv[8];
#pragma unroll
        for (int k = 0; k < 3; ++k)
#pragma unroll
            for (int e = 0; e < 8; e += 4) { const f32x4 a = *(const f32x4*)(cw + (size_t)k * NUP + j0 + e), b2 = *(const f32x4*)(cw + (size_t)k * NUP + DFF + j0 + e);
                wg[k][e] = a[0]; wg[k][e + 1] = a[1]; wg[k][e + 2] = a[2]; wg[k][e + 3] = a[3]; wv[k][e] = b2[0]; wv[k][e + 1] = b2[1]; wv[k][e + 2] = b2[2]; wv[k][e + 3] = b2[3]; }
#pragma unroll
        for (int e = 0; e < 8; e += 4) { const f32x4 a = *(const f32x4*)(cb + j0 + e), b2 = *(const f32x4*)(cb + DFF + j0 + e);
            bg[e] = a[0]; bg[e + 1] = a[1]; bg[e + 2] = a[2]; bg[e + 3] = a[3]; bv[e] = b2[0]; bv[e + 1] = b2[1]; bv[e + 2] = b2[2]; bv[e + 3] = b2[3]; }
        const u32x4 zero4 = (u32x4){0u, 0u, 0u, 0u};
        u32x4 pg = ((t0 & (SEQ - 1)) == 0) ? zero4 : *(const u32x4*)(U + (size_t)(t0 - 1) * NUP + j0);
        u32x4 pv = ((t0 & (SEQ - 1)) == 0) ? zero4 : *(const u32x4*)(U + (size_t)(t0 - 1) * NUP + DFF + j0);
        u32x4 cg_ = *(const u32x4*)(U + (size_t)t0 * NUP + j0), cv = *(const u32x4*)(U + (size_t)t0 * NUP + DFF + j0);
#pragma unroll 2
        for (int t = t0; t < t0 + TT; ++t) {
            const bool edge = (((t + 1) & (SEQ - 1)) == 0);
            const u32x4 ng = edge ? zero4 : *(const u32x4*)(U + (size_t)(t + 1) * NUP + j0);
            const u32x4 nv = edge ? zero4 : *(const u32x4*)(U + (size_t)(t + 1) * NUP + DFF + j0);
            float r[8];
#pragma unroll
            for (int e2 = 0; e2 < 4; ++e2) {
#pragma unroll
                for (int hh = 0; hh < 2; ++hh) {
                    const int e = 2 * e2 + hh;
                    const float g0 = hh ? bfhi(pg[e2]) : bflo(pg[e2]), g1 = hh ? bfhi(cg_[e2]) : bflo(cg_[e2]), g2 = hh ? bfhi(ng[e2]) : bflo(ng[e2]);
                    const float v0 = hh ? bfhi(pv[e2]) : bflo(pv[e2]), v1 = hh ? bfhi(cv[e2]) : bflo(cv[e2]), v2 = hh ? bfhi(nv[e2]) : bflo(nv[e2]);
                    const float gg = bg[e] + wg[0][e] * g0 + wg[1][e] * g1 + wg[2][e] * g2;
                    const float vv = bv[e] + wv[0][e] * v0 + wv[1][e] * v1 + wv[2][e] * v2;
                    r[e] = gg * __builtin_amdgcn_rcpf(1.f + __expf(-gg)) * vv;
                }
            }
            u32x4 o; o.x = cvt_pk_bf16(r[0], r[1]); o.y = cvt_pk_bf16(r[2], r[3]); o.z = cvt_pk_bf16(r[4], r[5]); o.w = cvt_pk_bf16(r[6], r[7]);
            *(u32x4*)(ACT + (size_t)t * DFF + j0) = o;
            if (edge) {
                pg = zero4; pv = zero4;
                if (t + 1 < t0 + TT) { cg_ = *(const u32x4*)(U + (size_t)(t + 1) * NUP + j0); cv = *(const u32x4*)(U + (size_t)(t + 1) * NUP + DFF + j0); }
            } else { pg = cg_; pv = cv; cg_ = ng; cv = nv; }
        }
    }
}
__device__ __forceinline__ void phase_attn_win(const Args& args, LAS unsigned char* lds, int j) {
    unsigned char* ws = args.ws; asm volatile("" : "+s"(ws));
    const bf16_t* QKV = (const bf16_t*)(ws + WS_QKV); bf16_t* OB = (bf16_t*)(ws + WS_OB);
    const float* sink = args.in[I_ASINK] + j * 32; const int G = gridDim.x;
    for (int u = blockIdx.x; u < 2048; u += G) {
        const int h = u & 31, qb = (u >> 5) & 31, b = u >> 10;
        const AttnPtrs P{QKV, NQKV, h * 64, QKV, NQKV, 2048 + (h >> 3) * 64, nullptr, 0, QKV, NQKV, 2304 + (h >> 3) * 64, OB, D, h * 64};
        const float slope = exp2f(-0.25f * (float)(h + 1)) * LOG2E;
        attn_unit<64, 64, true>(lds, b, qb, P, nullptr, nullptr, slope, sink[h] * LOG2E);
    }
}
__device__ __forceinline__ void phase_attn_mla(const Args& args, LAS unsigned char* lds) {
    unsigned char* ws = args.ws; asm volatile("" : "+s"(ws));
    const bf16_t* QM = (const bf16_t*)(ws + WS_Q); const bf16_t* KVM = (const bf16_t*)(ws + WS_KV); const bf16_t* KR = (const bf16_t*)(ws + WS_KR); bf16_t* OB = (bf16_t*)(ws + WS_OB);
    const float* cosT = (const float*)(ws + WS_ROPE); const float* sinT = cosT + SEQ * 32;
    const int G = gridDim.x, bx = blockIdx.x;
    for (int u = bx; u < 1024; u += G) {
        int bh, qb;
        if (G == 256) { bh = (bx & 7) * 4 + (u >> 8); qb = bx >> 3; } else { bh = u >> 5; qb = u & 31; }
        const int b = bh >> 4, h = bh & 15;
        const AttnPtrs P{QM, NUQ, h * 192, KVM, NUKV, h * 256, KR, 64, KVM, NUKV, h * 256 + 128, OB, D, h * 128};
        attn_unit<192, 128, false>(lds, b, qb, P, cosT, sinT, 0.f, 0.f);
    }
}
__device__ __forceinline__ void phase_s5(const Args& args, LAS unsigned char* lds, int ssq_idx) {
    FRESH_IDS();
    const float* X = args.out;
    constexpr int XP = 132, CH = 16, NCH = SEQ / CH, SEGC = NCH / 4;
    LAS float* hbuf = (LAS float*)(lds + wave * 9728);
    LAS float* Xs = hbuf + 256;
    LAS float* Sst = (LAS float*)(lds + 8 * 9728);
    const int fr = lane & 15, fq = lane >> 4, part = lane & 3, tlq = lane >> 2;
    const float* ssq_in = SSQ(ssq_idx);
    for (int pair = bx; pair < 256; pair += G) {
        const int seq = pair * 2 + (wave >> 2), seg = wave & 3;
        const int g = seq & 127, dir = (seq >> 7) & 1, b = seq >> 8;
        const size_t pidx = (size_t)(dir * 128 + g) * 64 + lane;
        float lbr, lbi; bf16x8 Bh[8];
        {
            const float* spb = (const float*)(ws + WS_S5P) + (size_t)(dir * 128 + g) * 64 * 64;
            const f32x4 l4 = *(const f32x4*)(spb + lane * 64); lbr = l4[0]; lbi = l4[1];
#pragma unroll
            for (int nt = 0; nt < 8; ++nt) {
                const float* p = spb + (16 * (nt & 3) + fr) * 64 + (nt < 4 ? 4 : 20) + 8 * (fq & 1);
                const f32x4 a = *(const f32x4*)p, b2 = *(const f32x4*)(p + 4);
                u32x4 w; w.x = cvt_pk_bf16(a[0], a[1]); w.y = cvt_pk_bf16(a[2], a[3]); w.z = cvt_pk_bf16(b2[0], b2[1]); w.w = cvt_pk_bf16(b2[2], b2[3]);
                if (fq >= 2) w = (u32x4){0u, 0u, 0u, 0u};
                Bh[nt] = __builtin_bit_cast(bf16x8, w);
            }
        }
        const f32x4 gain4 = *(const f32x4*)(args.in[I_MIXN] + 1 * D + g * 16 + part * 4);
        const size_t rowb = (size_t)b * SEQ;
        float xr = 0.f, xi = 0.f;
        f32x4 nv, npa, npb;
#define S5_LOAD(cidx) do { const int c0_ = dir ? (NCH - 1 - (cidx)) : (cidx); const size_t row_ = rowb + (size_t)c0_ * CH + tlq; \
            nv = *(const f32x4*)(X + row_ * D + g * 16 + part * 4); npa = *(const f32x4*)(ssq_in + ssq_at((int)row_, 2 * part)); npb = *(const f32x4*)(ssq_in + ssq_at((int)row_, 2 * part + 1)); } while (0)
#define S5_STAGE() do { float sq_ = ((npa[0] + npa[1]) + (npa[2] + npa[3])) + ((npb[0] + npb[1]) + (npb[2] + npb[3])); sq_ += __shfl_xor(sq_, 1); sq_ += __shfl_xor(sq_, 2); \
            const float rs_ = __builtin_amdgcn_rsqf(sq_ * (1.f / D) + EPS); *(LAS f32x4*)(hbuf + tlq * 16 + part * 4) = nv * rs_ * gain4; } while (0)
#define S5_BU() do {   \
            const f32x4 h0_ = *(const LAS f32x4*)(hbuf + fr * 16 + 8 * (fq & 1)), h1_ = *(const LAS f32x4*)(hbuf + fr * 16 + 8 * (fq & 1) + 4); \
            bf16x8 ah_, al_; split_bf16x8(h0_, h1_, ah_, al_); \
            if (fq >= 2) { ah_ = (bf16x8){0, 0, 0, 0, 0, 0, 0, 0}; al_ = ah_; } \
            _Pragma("unroll") for (int nt = 0; nt < 8; ++nt) { f32x4 d_ = (f32x4){0.f, 0.f, 0.f, 0.f}; \
                d_ = __builtin_amdgcn_mfma_f32_16x16x32_bf16(ah_, Bh[nt], d_, 0, 0, 0); \
                _Pragma("unroll") for (int r_ = 0; r_ < 4; ++r_) Xs[(4 * fq + r_) * XP + 16 * nt + fr] = d_[r_]; } } while (0)
#define S5_STEP(tl, STORE) do { \
            const float bur = Xs[(tl) * XP + lane], bui = Xs[(tl) * XP + 64 + lane]; \
            const float nxr = fmaf(lbr, xr, fmaf(-lbi, xi, bur)), nxi = fmaf(lbr, xi, fmaf(lbi, xr, bui)); xr = nxr; xi = nxi; \
            if (STORE) { Xs[(tl) * XP + lane] = xr; Xs[(tl) * XP + 64 + lane] = xi; } } while (0)
        const int cbeg = seg * SEGC, cend = cbeg + SEGC;
        S5_LOAD(cbeg);
#pragma unroll 1
        for (int ci = cbeg; ci < cend; ++ci) {
            S5_STAGE();
            if (ci + 1 < cend) S5_LOAD(ci + 1);
            asm volatile("s_waitcnt lgkmcnt(0)" ::: "memory");
            S5_BU();
            asm volatile("s_waitcnt lgkmcnt(0)" ::: "memory");
#pragma unroll 4
            for (int i = 0; i < CH; ++i) { const int tl = dir ? CH - 1 - i : i; S5_STEP(tl, false); }
            asm volatile("s_waitcnt lgkmcnt(0)" ::: "memory");
        }
        Sst[wave * 128 + lane] = xr; Sst[wave * 128 + 64 + lane] = xi;
        __syncthreads();
        {
            float pr = lbr, pi = lbi;
#pragma unroll
            for (int k = 0; k < 11; ++k) { const float nr = pr * pr - pi * pi, ni = 2.f * pr * pi; pr = nr; pi = ni; }
            xr = 0.f; xi = 0.f;
            for (int j = 0; j < seg; ++j) { const float sr = Sst[((wave & ~3) + j) * 128 + lane], si = Sst[((wave & ~3) + j) * 128 + 64 + lane];
                const float nr = fmaf(pr, xr, fmaf(-pi, xi, sr)), ni = fmaf(pr, xi, fmaf(pi, xr, si)); xr = nr; xi = ni; }
        }
        bf16x8 Ch[4];
        {
            const float* cre_p = args.in[I_SCRE] + ((size_t)(dir * 128 + g) * 16 + fr) * 64; const float* cim_p = args.in[I_SCIM] + ((size_t)(dir * 128 + g) * 16 + fr) * 64;
#pragma unroll
            for (int kk = 0; kk < 4; ++kk) {
                const float* p = (kk < 2 ? cre_p + 32 * kk : cim_p + 32 * (kk - 2)) + 8 * fq; const float sg = (kk < 2) ? 1.f : -1.f;
                const f32x4 a = *(const f32x4*)p * sg, b2 = *(const f32x4*)(p + 4) * sg;
                u32x4 w; w.x = cvt_pk_bf16(a[0], a[1]); w.y = cvt_pk_bf16(a[2], a[3]); w.z = cvt_pk_bf16(b2[0], b2[1]); w.w = cvt_pk_bf16(b2[2], b2[3]);
                Ch[kk] = __builtin_bit_cast(bf16x8, w);
            }
        }
        const float dsk = args.in[I_SD][g * 16 + fr];
        float* Y = (float*)(ws + (dir ? WS_YR : WS_YF));
        S5_LOAD(cbeg);
#pragma unroll 1
        for (int ci = cbeg; ci < cend; ++ci) {
            S5_STAGE();
            if (ci + 1 < cend) S5_LOAD(ci + 1);
            asm volatile("s_waitcnt lgkmcnt(0)" ::: "memory");
            S5_BU();
            asm volatile("s_waitcnt lgkmcnt(0)" ::: "memory");
#pragma unroll 4
            for (int i = 0; i < CH; ++i) { const int tl = dir ? CH - 1 - i : i; S5_STEP(tl, true); }
            asm volatile("s_waitcnt lgkmcnt(0)" ::: "memory");
            f32x4 acc = (f32x4){0.f, 0.f, 0.f, 0.f};
#pragma unroll
            for (int kk = 0; kk < 4; ++kk) {
                const f32x4 x0 = *(const LAS f32x4*)(Xs + fr * XP + 32 * kk + 8 * fq), x1 = *(const LAS f32x4*)(Xs + fr * XP + 32 * kk + 8 * fq + 4);
                bf16x8 xh, xl; split_bf16x8(x0, x1, xh, xl);
                acc = __builtin_amdgcn_mfma_f32_16x16x32_bf16(xh, Ch[kk], acc, 0, 0, 0);
            }
            const int c0 = dir ? (NCH - 1 - ci) : ci; const size_t tbase = rowb + (size_t)c0 * CH;
#pragma unroll
            for (int jj = 0; jj < 4; ++jj) {
                const int tl = 4 * fq + jj; float val = acc[jj];
                if (dir == 0) val += dsk * hbuf[tl * 16 + fr];
                Y[(tbase + tl) * D + g * 16 + fr] = val;
            }
            asm volatile("s_waitcnt lgkmcnt(0)" ::: "memory");
        }
        __syncthreads();
#undef S5_LOAD
#undef S5_STAGE
#undef S5_STEP
#undef S5_BU
    }
}
__device__ __forceinline__ void phase_gelu(const Args& args) {
    FRESH_IDS();
    const f32x4* YF = (const f32x4*)(ws + WS_YF); const f32x4* YR = (const f32x4*)(ws + WS_YR); u32x2* OB = (u32x2*)(ws + WS_OB);
    for (size_t i = gt; i < (size_t)T * D / 4; i += NGT) {
        const f32x4 a = YF[i], c = YR[i]; float z[4];
#pragma unroll
        for (int e = 0; e < 4; ++e) { const float y = a[e] + c[e]; const float u2 = 1.5957691216057308f * (y + 0.044715f * y * y * y); z[e] = y * __builtin_amdgcn_rcpf(1.f + __expf(-u2)); }
        u32x2 w; w.x = cvt_pk_bf16(z[0], z[1]); w.y = cvt_pk_bf16(z[2], z[3]); OB[i] = w;
    }
}
__device__ __forceinline__ void phase_final(const Args& args) {
    FRESH_IDS();
    const float* ssq_f = SSQ(8); const float* gf = args.in[I_FINN]; float* X = args.out;
    for (int row = gw; row < T; row += NGW) {
        const float rs = __builtin_amdgcn_rsqf(wave_sum(lane < 32 ? ssq_f[ssq_at(row, lane >> 2) + (lane & 3)] : 0.f) * (1.f / D) + EPS);
        f32x4* xr = (f32x4*)(X + (size_t)row * D) + lane; const f32x4* gr = (const f32x4*)gf + lane;
#pragma unroll
        for (int j = 0; j < 8; ++j) { f32x4 v = xr[64 * j]; v = v * rs * gr[64 * j]; xr[64 * j] = v; }
    }
}

__device__ __forceinline__ void my_barrier(unsigned* cnt, unsigned target) {
    __syncthreads();
    if (threadIdx.x == 0) {
        __builtin_amdgcn_fence(__ATOMIC_RELEASE, "agent"); asm volatile("s_waitcnt vmcnt(0) lgkmcnt(0)" ::: "memory");
        __hip_atomic_fetch_add(cnt, 1u, __ATOMIC_RELAXED, __HIP_MEMORY_SCOPE_AGENT);
        while (__hip_atomic_load(cnt, __ATOMIC_RELAXED, __HIP_MEMORY_SCOPE_AGENT) < target) __builtin_amdgcn_s_sleep(2);
        __builtin_amdgcn_fence(__ATOMIC_ACQUIRE, "agent"); asm volatile("s_waitcnt vmcnt(0)" ::: "memory");
    }
    __syncthreads();
}
__global__ void __launch_bounds__(512, 2) fwd_kernel(Args args) {
    extern __shared__ __attribute__((aligned(16))) unsigned char lds_raw[];
    LAS unsigned char* lds = (LAS unsigned char*)lds_raw;
    cg::grid_group grid = cg::this_grid();
    unsigned nbar = 0;
    if (blockIdx.x == 0 && threadIdx.x == 0) __hip_atomic_store((unsigned*)(args.ws + WS_BAR), 0u, __ATOMIC_RELEASE, __HIP_MEMORY_SCOPE_AGENT);
#define GRID_SYNC() do { asm volatile("s_waitcnt vmcnt(0) lgkmcnt(0)" ::: "memory"); if (nbar == 0) grid.sync(); my_barrier((unsigned*)(args.ws + WS_BAR), (++nbar) * gridDim.x); } while (0)
    GRID_SYNC();
    phase_prologue(args, lds);
    GRID_SYNC();
#pragma unroll 1
    for (int l = 0; l < 4; ++l) {
        const int kind = l % 3, j = l / 3;
        size_t w_o;
        if (kind == 0) {
            phase_gemm_scale(args, lds, WS_XB, D, j ? W_QKV1 : W_QKV0, NQKV, D, WS_QKV, 2 * l, 1.f / D, false);
            GRID_SYNC();
            phase_attn_win(args, lds, j);
            w_o = j ? W_WO1 : W_WO0;
        } else if (kind == 1) {
            phase_s5(args, lds, 2 * l);
            GRID_SYNC();
            phase_gelu(args);
            w_o = W_GLU;
        } else {
            phase_dqkv(args, lds, 2 * l);
            GRID_SYNC();
            phase_gemm_scale(args, lds, WS_CQ, 512, W_UQ, NUQ, 512, WS_Q, 9, 1.f / 512, true);
            phase_gemm_scale(args, lds, WS_CKV, 512, W_UKV, NUKV, 512, WS_KV, 10, 1.f / 512, true);
            GRID_SYNC();
            phase_attn_mla(args, lds);
            w_o = W_MWO;
        }
        GRID_SYNC();
        phase_gemm_resid(args, lds, WS_OB, w_o, D, l == 0 ? args.in[I_X] : args.out, 2 * l + 1, kind == 1);
        GRID_SYNC();
        phase_gemm_scale(args, lds, WS_XB, D, W_UP + (size_t)l * 44 * MiB, NUP, D, WS_U, 2 * l + 1, 1.f / D, false);
        GRID_SYNC();
        phase_conv(args, l);
        GRID_SYNC();
        phase_gemm_resid(args, lds, WS_ACT, W_DOWN + (size_t)l * 22 * MiB, DFF, args.out, 2 * l + 2, false);
        GRID_SYNC();
    }
    phase_final(args);
}

extern "C" void kernel_launch(void* const* d_in, const int* in_sizes, int n_in, void* d_out, int out_size, void* d_ws, size_t ws_size, hipStream_t stream) {
    static int grid = 0;
    if (grid == 0) {
        if (n_in != 27 || out_size != T * D || ws_size < WS_END) { fprintf(stderr, "kernel_launch: unexpected problem (n_in %d out %d ws %zu need %zu)\n", n_in, out_size, ws_size, (size_t)WS_END); grid = -1; return; }
        int dev = 0, cus = 0, per_cu = 0;
        (void)hipGetDevice(&dev);
        (void)hipDeviceGetAttribute(&cus, hipDeviceAttributeMultiprocessorCount, dev);
        (void)hipFuncSetAttribute((const void*)fwd_kernel, hipFuncAttributeMaxDynamicSharedMemorySize, LDS_BYTES);
        (void)hipOccupancyMaxActiveBlocksPerMultiprocessor(&per_cu, (const void*)fwd_kernel, 512, LDS_BYTES);
        if (per_cu < 1) per_cu = 1;
        grid = cus * per_cu;
        (void)hipGetLastError();
    }
    if (grid < 0) return;
    (void)hipMemsetAsync(d_ws, 0, 256, stream);
    Args a{};
    for (int i = 0; i < 27; ++i) a.in[i] = (const float*)d_in[i];
    a.out = (float*)d_out; a.ws = (unsigned char*)d_ws;
    void* kargs[] = {&a};
    hipError_t e = hipLaunchCooperativeKernel((void*)fwd_kernel, dim3(grid), dim3(512), kargs, LDS_BYTES, stream);
    if (e != hipSuccess) fprintf(stderr, "cooperative launch failed: %s (grid %d)\n", hipGetErrorString(e), grid);
}
```
